# Optimizing an MI355X kernel written in HIP

```python
import math
import jax
import jax.numpy as jnp
from jax import lax
import numpy as np

D_MODEL = 1024
BATCH = 32
SEQ = 2048
DEPTH = 2

D_CONV = D_MODEL // 4
CONV_GROUPS = 4
CONV_WIDTH = 3
D_POOL = D_MODEL // 4
POOL_WINDOWS = (2, 4, 8, 16)
N_POOL = len(POOL_WINDOWS)
POOL_GROUP = D_POOL // N_POOL
D_ATTN = D_MODEL - D_CONV - D_POOL
HEAD_DIM = 64
N_HEADS = D_ATTN // HEAD_DIM
N_KV = 2
HPG = N_HEADS // N_KV
D_KV = N_KV * HEAD_DIM
D_MIX = D_CONV + D_ATTN + D_POOL

CMP_BLOCK = 32
CMP_STRIDE = 16
SEL_BLOCK = 64
TOP_N = 8
WINDOW = 512
N_BRANCH = 3
Q_BLOCK = 64

NUM_BUCKETS = 32
MAX_DISTANCE = 128

D_FF = ((8 * D_MODEL // 3 + 255) // 256) * 256
ALPHA = (2 * DEPTH) ** 0.25
BETA = (8 * DEPTH) ** -0.25
LN_EPS = 1e-5
NEG = -1e30
FORCE = 1e6

SPLIT_SIZES = (D_CONV, D_CONV, D_CONV, D_ATTN, D_KV, D_KV, D_KV, D_KV, D_KV, D_KV, N_BRANCH * N_HEADS, D_POOL)
D_IN = sum(SPLIT_SIZES)
SPLIT_POINTS = tuple(sum(SPLIT_SIZES[:i + 1]) for i in range(len(SPLIT_SIZES) - 1))

kernel_name = "hymba_style_conv_nsa_pool_hybrid"


def layer_norm(x, g, b):
    xf = x.astype(jnp.float32)
    mu = jnp.mean(xf, axis=-1, keepdims=True)
    var = jnp.mean(jnp.square(xf - mu), axis=-1, keepdims=True)
    return ((xf - mu) * lax.rsqrt(var + LN_EPS) * g + b).astype(x.dtype)


def t5_bucket(dist):
    n = jnp.maximum(dist, 0)
    max_exact = NUM_BUCKETS // 2
    nf = jnp.maximum(n, 1).astype(jnp.float32)
    large = max_exact + (jnp.log(nf / max_exact) / math.log(MAX_DISTANCE / max_exact)
                         * (NUM_BUCKETS - max_exact)).astype(jnp.int32)
    large = jnp.minimum(large, NUM_BUCKETS - 1)
    return jnp.where(n < max_exact, n, large)


def masked_softmax(s, valid):
    p = jax.nn.softmax(jnp.where(valid, s.astype(jnp.float32), NEG), axis=-1)
    return jnp.where(valid, p, 0.0)


def short_conv_mixer(b_gate, c_gate, x_conv, conv_w):
    u = c_gate * x_conv
    y = lax.conv_general_dilated(u, conv_w[:, None, :], window_strides=(1,),
                                 padding=[(CONV_WIDTH - 1, 0)],
                                 dimension_numbers=('NWC', 'WIO', 'NWC'),
                                 feature_group_count=D_CONV)
    return b_gate * y


def pool_mixer(u, pool_w, pool_scale):
    B, S, _ = u.shape
    uf = u.astype(jnp.float32)
    cs = jnp.pad(jnp.cumsum(uf, axis=1), ((0, 0), (1, 0), (0, 0)))
    t = jnp.arange(1, S + 1)
    groups = []
    for gi, w in enumerate(POOL_WINDOWS):
        sl = slice(gi * POOL_GROUP, (gi + 1) * POOL_GROUP)
        c = cs[..., sl]
        mean = (c[:, 1:] - jnp.take(c, jnp.maximum(t - w, 0), axis=1)) \
            / jnp.minimum(t, w).astype(jnp.float32)[:, None]
        groups.append(mean - uf[..., sl])
    d = jnp.stack(groups, axis=2).astype(u.dtype)
    y = jnp.einsum('bsgc,gcd->bsgd', d, pool_w) * pool_scale.reshape(N_POOL, POOL_GROUP)
    return y.reshape(B, S, D_POOL)


def nsa_mixer(q, k_cmp, v_cmp, k_slc, v_slc, k_win, v_win, gate_logits,
              cmp_pe, cmp_w1, cmp_w2, rel_bias):
    B, S, _ = q.shape
    nq = S // Q_BLOCK
    nc = (S - CMP_BLOCK) // CMP_STRIDE + 1
    nb = S // SEL_BLOCK
    n_sel = min(TOP_N, nb)
    scale = HEAD_DIM ** -0.5

    def heads_kv(t):
        return t.reshape(B, S, N_KV, HEAD_DIM).transpose(0, 2, 1, 3)

    def q_blocks(t, d):
        return t.reshape(B, nq, Q_BLOCK, N_KV, HPG, d).transpose(1, 0, 3, 4, 2, 5)

    qb_all = q_blocks(q, HEAD_DIM)
    gb_all = q_blocks(jax.nn.sigmoid(gate_logits), N_BRANCH)

    blk = np.arange(nc)[:, None] * CMP_STRIDE + np.arange(CMP_BLOCK)[None, :]

    def compress(kv, pe, w1, w2):
        z = (kv[:, :, blk] + pe).reshape(B, N_KV, nc, CMP_BLOCK * HEAD_DIM)
        return jnp.einsum('bgne,ed->bgnd', jax.nn.gelu(jnp.einsum('bgnf,fe->bgne', z, w1)), w2)

    kc = compress(heads_kv(k_cmp), cmp_pe[0], cmp_w1[0], cmp_w2[0])
    vc = compress(heads_kv(v_cmp), cmp_pe[1], cmp_w1[1], cmp_w2[1])
    cmp_start = np.arange(nc) * CMP_STRIDE
    cmp_end = jnp.asarray(cmp_start + CMP_BLOCK - 1, jnp.int32)

    sel_start = np.arange(nb) * SEL_BLOCK
    ov = np.clip(np.minimum(cmp_start[:, None] + CMP_BLOCK, sel_start[None, :] + SEL_BLOCK)
                 - np.maximum(cmp_start[:, None], sel_start[None, :]), 0, None) / CMP_STRIDE
    overlap = jnp.asarray(ov, jnp.float32)

    ks = heads_kv(k_slc).reshape(B, N_KV, nb, SEL_BLOCK, HEAD_DIM)
    vs = heads_kv(v_slc).reshape(B, N_KV, nb, SEL_BLOCK, HEAD_DIM)
    pad = ((0, 0), (0, 0), (WINDOW, 0), (0, 0))
    kw = jnp.pad(heads_kv(k_win), pad)
    vw = jnp.pad(heads_kv(v_win), pad)

    head_ids = jnp.arange(N_HEADS).reshape(N_KV, HPG)
    bias_flat = rel_bias.T.reshape(-1)

    def head_bias(dist):
        return rel_bias[t5_bucket(dist)].transpose(2, 0, 1).reshape(N_KV, HPG, *dist.shape)

    gather_blocks = jax.vmap(jax.vmap(lambda blocks, ix: blocks[ix]))

    def attend(args):
        qb, gb, s0 = args
        t = s0 + jnp.arange(Q_BLOCK)
        dist_c = t[:, None] - cmp_end[None, :]
        s_c = jnp.einsum('bghqd,bgnd->bghqn', qb, kc) * scale + head_bias(dist_c)
        p_c = masked_softmax(s_c, dist_c >= 0)
        o_c = jnp.einsum('bghqn,bgnd->bghqd', p_c.astype(vc.dtype), vc)
        imp = jnp.einsum('bghqn,nj->bgqj', p_c, overlap)
        cur = (t // SEL_BLOCK)[:, None]
        j = jnp.arange(nb)[None, :]
        forced = (j == 0) | (j == cur) | (j == cur - 1)
        imp = jnp.where(j * SEL_BLOCK <= t[:, None], imp + FORCE * forced, NEG)
        idx = lax.top_k(imp, n_sel)[1]
        kg = gather_blocks(ks, idx)
        vg = gather_blocks(vs, idx)
        dist_s = t[:, None, None] - (idx[..., None] * SEL_BLOCK + jnp.arange(SEL_BLOCK))
        bias_s = bias_flat[head_ids[None, :, :, None, None, None] * NUM_BUCKETS
                           + t5_bucket(dist_s)[:, :, None]]
        s_s = jnp.einsum('bghqd,bgqnkd->bghqnk', qb, kg) * scale + bias_s
        valid_s = (dist_s >= 0).reshape(B, N_KV, 1, Q_BLOCK, n_sel * SEL_BLOCK)
        p_s = masked_softmax(s_s.reshape(B, N_KV, HPG, Q_BLOCK, n_sel * SEL_BLOCK), valid_s)
        p_s = p_s.reshape(B, N_KV, HPG, Q_BLOCK, n_sel, SEL_BLOCK).astype(vg.dtype)
        o_s = jnp.einsum('bghqnk,bgqnkd->bghqd', p_s, vg)
        kwb = lax.dynamic_slice_in_dim(kw, s0, WINDOW + Q_BLOCK, axis=2)
        vwb = lax.dynamic_slice_in_dim(vw, s0, WINDOW + Q_BLOCK, axis=2)
        kpos = s0 - WINDOW + jnp.arange(WINDOW + Q_BLOCK)
        dist_w = t[:, None] - kpos[None, :]
        valid_w = (dist_w >= 0) & (dist_w < WINDOW) & (kpos[None, :] >= 0)
        s_w = jnp.einsum('bghqd,bgkd->bghqk', qb, kwb) * scale + head_bias(dist_w)
        p_w = masked_softmax(s_w, valid_w)
        o_w = jnp.einsum('bghqk,bgkd->bghqd', p_w.astype(vwb.dtype), vwb)
        return gb[..., 0:1] * o_c + gb[..., 1:2] * o_s + gb[..., 2:3] * o_w

    starts = jnp.arange(nq, dtype=jnp.int32) * Q_BLOCK
    o = lax.map(attend, (qb_all, gb_all, starts))
    return o.transpose(1, 0, 4, 2, 3, 5).reshape(B, S, D_ATTN)


def setup_inputs(seed: int = 0) -> dict:
    key = jax.random.key(seed)
    ks = jax.random.split(key, 17)
    f32 = jnp.float32

    def nrm(k, shape, scale):
        return jax.random.normal(k, shape, f32) * scale

    return {
        "x": nrm(ks[0], (BATCH, SEQ, D_MODEL), 1.0),
        "w_in": nrm(ks[1], (DEPTH, D_MODEL, D_IN), D_MODEL ** -0.5),
        "conv_w": nrm(ks[2], (DEPTH, CONV_WIDTH, D_CONV), CONV_WIDTH ** -0.5),
        "cmp_pe": nrm(ks[3], (DEPTH, 2, CMP_BLOCK, HEAD_DIM), 0.1),
        "cmp_w1": nrm(ks[4], (DEPTH, 2, CMP_BLOCK * HEAD_DIM, HEAD_DIM), (CMP_BLOCK * HEAD_DIM) ** -0.5),
        "cmp_w2": nrm(ks[5], (DEPTH, 2, HEAD_DIM, HEAD_DIM), HEAD_DIM ** -0.5),
        "pool_w": nrm(ks[6], (DEPTH, N_POOL, POOL_GROUP, POOL_GROUP), POOL_GROUP ** -0.5),
        "pool_scale": 1.0 + nrm(ks[7], (DEPTH, D_POOL), 0.1),
        "w_out": nrm(ks[8], (DEPTH, D_MIX, D_MODEL), BETA * D_MIX ** -0.5),
        "ln1_g": 1.0 + nrm(ks[9], (DEPTH, D_MODEL), 0.05),
        "ln1_b": nrm(ks[10], (DEPTH, D_MODEL), 0.02),
        "w_gate": nrm(ks[11], (DEPTH, D_MODEL, D_FF), D_MODEL ** -0.5),
        "w_up": nrm(ks[12], (DEPTH, D_MODEL, D_FF), D_MODEL ** -0.5),
        "w_down": nrm(ks[13], (DEPTH, D_FF, D_MODEL), BETA * D_FF ** -0.5),
        "ln2_g": 1.0 + nrm(ks[14], (DEPTH, D_MODEL), 0.05),
        "ln2_b": nrm(ks[15], (DEPTH, D_MODEL), 0.02),
        "rel_bias": nrm(ks[16], (NUM_BUCKETS, N_HEADS), 0.5),
    }


def reference(x, w_in, conv_w, cmp_pe, cmp_w1, cmp_w2, pool_w, pool_scale, w_out,
              ln1_g, ln1_b, w_gate, w_up, w_down, ln2_g, ln2_b, rel_bias):
    for l in range(DEPTH):
        h = jnp.einsum('bsd,de->bse', x, w_in[l])
        (b_gate, c_gate, x_conv, q, k_cmp, v_cmp, k_slc, v_slc, k_win, v_win,
         gate_logits, x_pool) = jnp.split(h, SPLIT_POINTS, axis=-1)
        y_a = short_conv_mixer(b_gate, c_gate, x_conv, conv_w[l])
        y_b = nsa_mixer(q, k_cmp, v_cmp, k_slc, v_slc, k_win, v_win, gate_logits,
                        cmp_pe[l], cmp_w1[l], cmp_w2[l], rel_bias)
        y_c = pool_mixer(x_pool, pool_w[l], pool_scale[l])
        mix = jnp.concatenate([y_a, y_b.astype(y_a.dtype), y_c], axis=-1)
        x = layer_norm(ALPHA * x + jnp.einsum('bsm,md->bsd', mix, w_out[l]), ln1_g[l], ln1_b[l])
        ffn = jnp.einsum('bsf,fd->bsd',
                         jax.nn.silu(jnp.einsum('bsd,df->bsf', x, w_gate[l]))
                         * jnp.einsum('bsd,df->bsf', x, w_up[l]), w_down[l])
        x = layer_norm(ALPHA * x + ffn, ln2_g[l], ln2_b[l])
    return x
```

```cpp
#include <hip/hip_runtime.h>
#include <hip/hip_cooperative_groups.h>
#include <cstdio>
#include <cstdint>
namespace cg = cooperative_groups;

typedef _Float16 h16;
typedef _Float16 half8 __attribute__((ext_vector_type(8)));
typedef _Float16 half4 __attribute__((ext_vector_type(4)));
typedef float f32x4 __attribute__((ext_vector_type(4)));
#define DI __device__ __forceinline__
__device__ __forceinline__ int opaque_tid() { int t = threadIdx.x; asm volatile("" : "+v"(t)); return t; }
#define MFMA16(a, b, c) __builtin_amdgcn_mfma_f32_16x16x32_f16((a), (b), (c), 0, 0, 0)

constexpr int SEQ = 2048, BATCH = 32, MTOK = BATCH * SEQ, DM = 1024, DIN = 2328, LDH = 2560, DFF = 2816;
constexpr int C_BG = 0, C_CG = 256, C_XC = 512, C_Q = 768, C_KC = 1280, C_VC = 1408, C_KS = 1536, C_VS = 1664, C_KW = 1792, C_VW = 1920, C_GL = 2048, C_XP = 2072;
constexpr float ALPHA_F = 1.41421356237309515f;
constexpr float NEGF = -1e30f;
constexpr int NPHASE = 17;

constexpr size_t SZ_WIN = (size_t)LDH * 1024 * 2, SZ_WOUT = (size_t)1024 * 1024 * 2, SZ_WGU = (size_t)5632 * 1024 * 2, SZ_WDN = (size_t)1024 * DFF * 2;
constexpr size_t OFF_WIN = 0;
constexpr size_t OFF_WOUT = OFF_WIN + 2 * SZ_WIN;
constexpr size_t OFF_WGU = OFF_WOUT + 2 * SZ_WOUT;
constexpr size_t OFF_WDN = OFF_WGU + 2 * SZ_WGU;
constexpr size_t OFF_W1T = OFF_WDN + 2 * SZ_WDN;
constexpr size_t OFF_W2T = OFF_W1T + 4 * 64 * 2048 * 2;
constexpr size_t OFF_PE = OFF_W2T + 4 * 64 * 64 * 2;
constexpr size_t OFF_TAB = OFF_PE + 4 * 32 * 64 * 2;
constexpr size_t OFF_KC = OFF_TAB + 8192;
constexpr size_t OFF_VCT = OFF_KC + 64 * 128 * 64 * 2;
constexpr size_t OFF_VST = OFF_VCT + 64 * 128 * 64 * 2;
constexpr size_t OFF_VWT = OFF_VST + (size_t)64 * 64 * 2048 * 2;
constexpr size_t OFF_XA = OFF_VWT + (size_t)64 * 64 * 2048 * 2;
constexpr size_t OFF_MIX = OFF_XA + (size_t)MTOK * 1024 * 2;
constexpr size_t OFF_Y = OFF_MIX + (size_t)MTOK * 1024 * 2;
constexpr size_t OFF_H = OFF_Y + (size_t)MTOK * 1024 * 2;
constexpr size_t WS_NEED = OFF_H + (size_t)MTOK * DFF * 2;

constexpr int LDS_BYTES = 131072;

struct Params {
  const float *x, *w_in, *conv_w, *cmp_pe, *cmp_w1, *cmp_w2, *pool_w, *pool_scale, *w_out, *ln1_g, *ln1_b, *w_gate, *w_up, *w_down, *ln2_g, *ln2_b, *rel_bias;
  float* out;
  unsigned char* ws;
  int phase_lo, phase_hi;
};

extern __shared__ __attribute__((aligned(16))) unsigned char smem[];

constexpr int BK = 64, HALF = 128, HT = HALF * BK;
DI int lds_byte(int r, int c) { int st = (r >> 4) * 2 + (c >> 5), rr = r & 15, cc = c & 31, ob = rr * 64 + cc * 2; return st * 1024 + (ob ^ (((ob >> 9) & 1) << 5)); }
DI void stage_rc(int b, int& R, int& C) { int st = b / 1024, sb = b % 1024, swz = sb ^ (((sb >> 9) & 1) << 5); R = (st >> 1) * 16 + swz / 64; C = (st & 1) * 32 + (swz % 64) / 2; }

struct EpiArgs { h16* out; const h16* res; };

#define LAS __attribute__((address_space(3)))
DI int perm32(int rho) { const int n = rho >> 4, i = rho & 15; return 8 * (i >> 2) + 4 * n + (i & 3); }

template <int EPI>
DI void gemm_tile(const h16* __restrict__ A, const h16* __restrict__ Bt, const int K, const int brow, const int bcol, const EpiArgs ea) {
  LAS unsigned char* lds = (LAS unsigned char*)smem;
  const int tid = opaque_tid(), wid = __builtin_amdgcn_readfirstlane(tid >> 6), lane = tid & 63, wr = wid >> 2, wc = wid & 3, fr = lane & 15, fq = lane >> 4;
  unsigned voffA[2], voffB[2];
#pragma unroll
  for (int i = 0; i < 2; ++i) { int R, C; stage_rc(tid * 16 + i * 8192, R, C); const int Rb = (R & ~31) + perm32(R & 31);
    voffA[i] = (unsigned)(R * K + C) * 2u; voffB[i] = (unsigned)(Rb * K + C) * 2u; }
  const size_t kstep = (size_t)(BK * 2), hstep = (size_t)HALF * K * 2;
  const unsigned ldsw = (unsigned)wid * 1024u;
  const int aoff = lds_byte(wr * 64 + fr, fq * 8), boff = lds_byte(wc * 32 + fr, fq * 8);
  constexpr int HTB = HT * 2;
#define SA(b, h) (((b) * 2 + (h)) * HTB)
#define SB(b, h) ((4 + (b) * 2 + (h)) * HTB)
#define STAGE(bufoff, gbase, voff) do { _Pragma("unroll") for (int _i = 0; _i < 2; ++_i) \
    __builtin_amdgcn_global_load_lds((const unsigned*)((const char*)(gbase) + (voff)[_i]), (LAS unsigned*)(lds + (bufoff) + ldsw + _i * 8192), 16, 0, 0); } while (0)
#define LDA(dst, b, h) do { _Pragma("unroll") for (int m = 0; m < 4; ++m) _Pragma("unroll") for (int k = 0; k < 2; ++k) dst[m][k] = *(const LAS half8*)(lds + SA(b, h) + aoff + m * 2048 + k * 1024); } while (0)
#define LDB(dst, b, h) do { _Pragma("unroll") for (int n = 0; n < 2; ++n) _Pragma("unroll") for (int k = 0; k < 2; ++k) dst[n][k] = *(const LAS half8*)(lds + SB(b, h) + boff + n * 2048 + k * 1024); } while (0)
#define MMA(ai, bj, At_, Bt_) do { __builtin_amdgcn_s_setprio(1); \
    _Pragma("unroll") for (int m = 0; m < 4; ++m) _Pragma("unroll") for (int n = 0; n < 2; ++n) _Pragma("unroll") for (int k = 0; k < 2; ++k) \
      acc[ai][bj][m][n] = MFMA16(Bt_[n][k], At_[m][k], acc[ai][bj][m][n]); \
    __builtin_amdgcn_s_setprio(0); } while (0)
#define WAIT_V(n) asm volatile("s_waitcnt vmcnt(" #n ")" ::: "memory")
#define WAIT_L(n) asm volatile("s_waitcnt lgkmcnt(" #n ")" ::: "memory")
#define BAR __builtin_amdgcn_s_barrier()
#define SCHED __builtin_amdgcn_sched_barrier(0)
  f32x4 acc[2][2][4][2];
#pragma unroll
  for (int a = 0; a < 2; ++a)
#pragma unroll
    for (int b = 0; b < 2; ++b)
#pragma unroll
      for (int m = 0; m < 4; ++m)
#pragma unroll
        for (int n = 0; n < 2; ++n) acc[a][b][m][n] = (f32x4){0.f, 0.f, 0.f, 0.f};
  half8 At[4][2], B0[2][2], B1[2][2];
  const int nt = K / BK;
  const char* cA = (const char*)A + (size_t)brow * K * 2;
  const char* cB = (const char*)Bt + (size_t)bcol * K * 2;
  STAGE(SB(0, 0), cB, voffB); STAGE(SA(0, 0), cA, voffA);
  STAGE(SB(0, 1), cB + hstep, voffB); STAGE(SA(0, 1), cA + hstep, voffA);
  if (wr == 1) BAR;
  WAIT_V(4); BAR;
  STAGE(SB(1, 0), cB + kstep, voffB); STAGE(SA(1, 0), cA + kstep, voffA); STAGE(SB(1, 1), cB + hstep + kstep, voffB);
  WAIT_V(6); BAR;
  for (int t = 0; t < nt - 2; t += 2) {
    const char* a1 = cA + (size_t)(t + 1) * kstep; const char* a2 = a1 + kstep; const char* a3 = a2 + kstep;
    const char* b2 = cB + (size_t)(t + 2) * kstep; const char* b3 = b2 + kstep;
    LDB(B0, 0, 0); SCHED; LDA(At, 0, 0); STAGE(SA(1, 1), a1 + hstep, voffA);
    WAIT_L(8); BAR; WAIT_L(0); MMA(0, 0, At, B0); BAR; SCHED;
    LDB(B1, 0, 1); STAGE(SB(0, 0), b2, voffB);
    BAR; WAIT_L(0); MMA(0, 1, At, B1); BAR;
    LDA(At, 0, 1); STAGE(SA(0, 0), a2, voffA);
    BAR; WAIT_L(0); MMA(1, 0, At, B0); BAR; SCHED;
    STAGE(SB(0, 1), b2 + hstep, voffB);
    WAIT_V(6); BAR; MMA(1, 1, At, B1); BAR;
    LDB(B0, 1, 0); SCHED; LDA(At, 1, 0); STAGE(SA(0, 1), a2 + hstep, voffA);
    WAIT_L(8); BAR; WAIT_L(0); MMA(0, 0, At, B0); BAR; SCHED;
    LDB(B1, 1, 1); STAGE(SB(1, 0), b3, voffB);
    BAR; WAIT_L(0); MMA(0, 1, At, B1); BAR;
    LDA(At, 1, 1); STAGE(SA(1, 0), a3, voffA);
    BAR; WAIT_L(0); MMA(1, 0, At, B0); BAR; SCHED;
    STAGE(SB(1, 1), b3 + hstep, voffB);
    WAIT_V(6); BAR; MMA(1, 1, At, B1); BAR;
  }
  { LDB(B0, 0, 0); LDA(At, 0, 0); STAGE(SA(1, 1), cA + (size_t)(nt - 1) * kstep + hstep, voffA);
    BAR; WAIT_L(0); MMA(0, 0, At, B0); BAR;
    LDB(B1, 0, 1); BAR; WAIT_L(0); MMA(0, 1, At, B1); BAR;
    LDA(At, 0, 1); WAIT_V(4); BAR; WAIT_L(0); MMA(1, 0, At, B0); MMA(1, 1, At, B1); BAR; }
  { LDB(B0, 1, 0); LDA(At, 1, 0); WAIT_V(2); BAR; WAIT_L(0); MMA(0, 0, At, B0); BAR;
    LDB(B1, 1, 1); WAIT_V(0); BAR; WAIT_L(0); MMA(0, 1, At, B1); BAR;
    LDA(At, 1, 1); BAR; WAIT_L(0); MMA(1, 0, At, B0); MMA(1, 1, At, B1); BAR; }
  if (wr == 0) BAR;
#pragma unroll
  for (int ai = 0; ai < 2; ++ai)
#pragma unroll
    for (int m = 0; m < 4; ++m) {
      const size_t row = (size_t)(brow + ai * HALF + wr * 64 + m * 16 + fr);
#pragma unroll
      for (int bj = 0; bj < 2; ++bj) {
        const int col0 = bcol + bj * HALF + wc * 32 + 8 * fq;
        const f32x4 v0 = acc[ai][bj][m][0], v1 = acc[ai][bj][m][1];
        if (EPI == 0) {
          half8 o = {(h16)v0[0], (h16)v0[1], (h16)v0[2], (h16)v0[3], (h16)v1[0], (h16)v1[1], (h16)v1[2], (h16)v1[3]};
          *(half8*)(ea.out + row * LDH + col0) = o;
        } else if (EPI == 1) {
          const half8 r = *(const half8*)(ea.res + row * 1024 + col0);
          half8 o;
#pragma unroll
          for (int j = 0; j < 4; ++j) { o[j] = (h16)(ALPHA_F * (float)r[j] + v0[j]); o[4 + j] = (h16)(ALPHA_F * (float)r[4 + j] + v1[j]); }
          *(half8*)(ea.out + row * 1024 + col0) = o;
        } else {
          const int f0 = (bcol + bj * HALF + wc * 32) / 2 + 4 * fq;
          half4 o;
#pragma unroll
          for (int j = 0; j < 4; ++j) { const float g = v0[j], u = v1[j]; o[j] = (h16)(g / (1.f + __expf(-g)) * u); }
          *(half4*)(ea.out + row * DFF + f0) = o;
        }
      }
      SCHED;
    }
  WAIT_V(0);
#undef SA
#undef SB
#undef STAGE
#undef LDA
#undef LDB
#undef MMA
}

template <int EPI>
DI void gemm_phase(const h16* A, const h16* Bt, int N, int K, EpiArgs ea) {
  const int nM = MTOK / 256, nN = N / 256, nwg = nM * nN;
  for (int L = blockIdx.x; L < nwg; L += gridDim.x) {
    int wgid = L;
    { const int q = nwg / 8, r = nwg % 8, xcd = wgid % 8, off = wgid / 8; wgid = (xcd < r ? xcd * (q + 1) : r * (q + 1) + (xcd - r) * q) + off; }
    const int nig = 8 * nN, gid = wgid / nig, fm = gid * 8, gsz = (nM - fm) < 8 ? (nM - fm) : 8;
    const int pm = fm + ((wgid % nig) % gsz), pn = (wgid % nig) / gsz;
    gemm_tile<EPI>(A, Bt, K, pm * 256, pn * 256, ea);
  }
}

DI int t5_bucket(int n) {
  if (n < 16) return n;
  int v = 16 + (int)(logf((float)n / 16.f) / 2.0794415416798357f * 16.f);
  return v > 31 ? 31 : v;
}

DI void prologue(const Params& p) {
  const int tid = opaque_tid();
  {
    const size_t n8 = (size_t)MTOK * 1024 / 8;
    half8* xa = (half8*)(p.ws + OFF_XA);
    const float4* xs = (const float4*)p.x;
    for (size_t i = (size_t)blockIdx.x * 512 + tid; i < n8; i += (size_t)gridDim.x * 512) {
      const float4 a = xs[2 * i], b = xs[2 * i + 1];
      half8 v = {(h16)a.x, (h16)a.y, (h16)a.z, (h16)a.w, (h16)b.x, (h16)b.y, (h16)b.z, (h16)b.w};
      xa[i] = v;
    }
  }
  {
    float* tile = (float*)smem;
    constexpr int PER_LAYER = 3074;
    for (int task = blockIdx.x; task < 2 * PER_LAYER; task += gridDim.x) {
      const int l = task / PER_LAYER; int r = task % PER_LAYER;
      const float* src0; const float* src1 = nullptr; int ld, K, kind, ntk; h16* dst;
      if (r < 640) { kind = 0; src0 = p.w_in + (size_t)l * 1024 * DIN; ld = DIN; K = 1024; dst = (h16*)(p.ws + OFF_WIN + l * SZ_WIN); }
      else if (r < 896) { r -= 640; kind = 1; src0 = p.w_out + (size_t)l * 1024 * 1024; ld = 1024; K = 1024; dst = (h16*)(p.ws + OFF_WOUT + l * SZ_WOUT); }
      else if (r < 2304) { r -= 896; kind = 2; src0 = p.w_gate + (size_t)l * 1024 * DFF; src1 = p.w_up + (size_t)l * 1024 * DFF; ld = DFF; K = 1024; dst = (h16*)(p.ws + OFF_WGU + l * SZ_WGU); }
      else if (r < 3008) { r -= 2304; kind = 1; src0 = p.w_down + (size_t)l * DFF * 1024; ld = 1024; K = DFF; dst = (h16*)(p.ws + OFF_WDN + l * SZ_WDN); }
      else if (r < 3072) { r -= 3008; const int kv = r / 32; r = r % 32; kind = 1; src0 = p.cmp_w1 + (size_t)(l * 2 + kv) * 2048 * 64; ld = 64; K = 2048; dst = (h16*)(p.ws + OFF_W1T) + (size_t)(l * 2 + kv) * 64 * 2048; }
      else { r -= 3072; const int kv = r; r = 0; kind = 1; src0 = p.cmp_w2 + (size_t)(l * 2 + kv) * 64 * 64; ld = 64; K = 64; dst = (h16*)(p.ws + OFF_W2T) + (size_t)(l * 2 + kv) * 64 * 64; }
      ntk = K / 64;
      const int n0 = (r / ntk) * 64, k0 = (r % ntk) * 64;
#pragma unroll
      for (int i = 0; i < 8; ++i) {
        const int e = tid + i * 512, kk = e >> 6, nn = e & 63, n = n0 + nn;
        float v;
        if (kind == 0) v = n < DIN ? src0[(size_t)(k0 + kk) * ld + n] : 0.f;
        else if (kind == 1) v = src0[(size_t)(k0 + kk) * ld + n];
        else { const int G = n >> 5, vv = n & 31, f = 16 * G + 4 * (vv >> 3) + (vv & 3), which = (vv >> 2) & 1; v = (which ? src1 : src0)[(size_t)(k0 + kk) * ld + f]; }
        tile[kk * 65 + nn] = v;
      }
      __syncthreads();
#pragma unroll
      for (int i = 0; i < 8; ++i) {
        const int e = tid + i * 512, nn = e >> 6, kk = e & 63;
        dst[(size_t)(n0 + nn) * K + k0 + kk] = (h16)tile[kk * 65 + nn];
      }
      __syncthreads();
    }
  }
  {
    h16* pe = (h16*)(p.ws + OFF_PE);
    for (int i = blockIdx.x * 512 + tid; i < 4 * 32 * 64; i += gridDim.x * 512) pe[i] = (h16)p.cmp_pe[i];
    float* tab = (float*)(p.ws + OFF_TAB);
    for (int i = blockIdx.x * 512 + tid; i < 8 * 132; i += gridDim.x * 512) {
      const int hh = i / 132, d = i % 132;
      tab[i] = p.rel_bias[t5_bucket(d > 128 ? 128 : d) * 8 + hh];
    }
  }
}

DI void ln_phase(const h16* __restrict__ y, const float* __restrict__ g, const float* __restrict__ b, h16* __restrict__ o16, float* __restrict__ o32) {
  const int tid_ = opaque_tid(); const int wave = tid_ >> 6, lane = tid_ & 63;
  float gg[16], bb[16];
#pragma unroll
  for (int c = 0; c < 2; ++c)
#pragma unroll
    for (int j = 0; j < 8; ++j) { gg[c * 8 + j] = g[c * 512 + lane * 8 + j]; bb[c * 8 + j] = b[c * 512 + lane * 8 + j]; }
  for (int row = blockIdx.x * 8 + wave; row < MTOK; row += gridDim.x * 8) {
    const h16* yr = y + (size_t)row * 1024;
    const half8 a0 = *(const half8*)(yr + lane * 8), a1 = *(const half8*)(yr + 512 + lane * 8);
    float v[16];
#pragma unroll
    for (int j = 0; j < 8; ++j) { v[j] = (float)a0[j]; v[8 + j] = (float)a1[j]; }
    float s = 0.f;
#pragma unroll
    for (int j = 0; j < 16; ++j) s += v[j];
#pragma unroll
    for (int o = 32; o >= 1; o >>= 1) s += __shfl_xor(s, o);
    const float mu = s * (1.f / 1024.f);
    float q = 0.f;
#pragma unroll
    for (int j = 0; j < 16; ++j) { const float d = v[j] - mu; q += d * d; }
#pragma unroll
    for (int o = 32; o >= 1; o >>= 1) q += __shfl_xor(q, o);
    const float rs = rsqrtf(q * (1.f / 1024.f) + 1e-5f);
    float r[16];
#pragma unroll
    for (int j = 0; j < 16; ++j) r[j] = (v[j] - mu) * rs * gg[j] + bb[j];
    half8 o0, o1;
#pragma unroll
    for (int j = 0; j < 8; ++j) { o0[j] = (h16)r[j]; o1[j] = (h16)r[8 + j]; }
    *(half8*)(o16 + (size_t)row * 1024 + lane * 8) = o0;
    *(half8*)(o16 + (size_t)row * 1024 + 512 + lane * 8) = o1;
    if (o32) {
      float* orow = o32 + (size_t)row * 1024;
      *(float4*)(orow + lane * 8) = make_float4(r[0], r[1], r[2], r[3]);
      *(float4*)(orow + lane * 8 + 4) = make_float4(r[4], r[5], r[6], r[7]);
      *(float4*)(orow + 512 + lane * 8) = make_float4(r[8], r[9], r[10], r[11]);
      *(float4*)(orow + 512 + lane * 8 + 4) = make_float4(r[12], r[13], r[14], r[15]);
    }
  }
}

DI float gelu_tanh(float x) {
  const float u = 0.7978845608028654f * (x + 0.044715f * x * x * x);
  const float t = __expf(2.f * u);
  const float th = 1.f - 2.f / (t + 1.f);
  return 0.5f * x * (1.f + th);
}

DI void mixers_phase(const Params& p, const int l) {
  const int tid = opaque_tid(), wave = tid >> 6, lane = tid & 63, fr = lane & 15, fq = lane >> 4;
  const h16* h = (const h16*)(p.ws + OFF_H);
  h16* mix = (h16*)(p.ws + OFF_MIX);
  h16* kc = (h16*)(p.ws + OFF_KC);
  h16* vcT = (h16*)(p.ws + OFF_VCT);
  for (int i = blockIdx.x * 512 + tid; i < 64 * 64; i += gridDim.x * 512) {
    const int bg = i >> 6, d = i & 63;
    kc[((size_t)bg * 128 + 127) * 64 + d] = (h16)0.f;
    vcT[((size_t)bg * 64 + d) * 128 + 127] = (h16)0.f;
  }
  {
    const int id = wave * gridDim.x + blockIdx.x;
    if (id < 1016) {
      const int kv = id / 508, rt = id % 508;
      const int r = rt * 16 + fr, bg = r / 127, n = r % 127, b = bg >> 1, g = bg & 1;
      const h16* zb = h + ((size_t)b * SEQ + n * 16) * LDH + (kv ? C_VC : C_KC) + g * 64;
      const h16* pe = (const h16*)(p.ws + OFF_PE) + (size_t)(l * 2 + kv) * 32 * 64;
      const h16* w1t = (const h16*)(p.ws + OFF_W1T) + (size_t)(l * 2 + kv) * 64 * 2048;
      const h16* w2t = (const h16*)(p.ws + OFF_W2T) + (size_t)(l * 2 + kv) * 64 * 64;
      f32x4 a1[4];
#pragma unroll
      for (int e = 0; e < 4; ++e) a1[e] = (f32x4){0.f, 0.f, 0.f, 0.f};
#pragma unroll 2
      for (int s = 0; s < 64; ++s) {
        const int i = s >> 1, d = (s & 1) * 32 + fq * 8;
        half8 zf = *(const half8*)(zb + (size_t)i * LDH + d);
        const half8 pf = *(const half8*)(pe + i * 64 + d);
        zf = zf + pf;
#pragma unroll
        for (int e = 0; e < 4; ++e) {
          const half8 wf = *(const half8*)(w1t + (size_t)(e * 16 + fr) * 2048 + s * 32 + fq * 8);
          a1[e] = MFMA16(wf, zf, a1[e]);
        }
      }
      f32x4 a2[4];
#pragma unroll
      for (int d = 0; d < 4; ++d) a2[d] = (f32x4){0.f, 0.f, 0.f, 0.f};
#pragma unroll
      for (int s2 = 0; s2 < 2; ++s2) {
        half8 gf;
#pragma unroll
        for (int j = 0; j < 4; ++j) { gf[j] = (h16)gelu_tanh(a1[2 * s2][j]); gf[4 + j] = (h16)gelu_tanh(a1[2 * s2 + 1][j]); }
#pragma unroll
        for (int dt = 0; dt < 4; ++dt) {
          const half4 w0 = *(const half4*)(w2t + (dt * 16 + fr) * 64 + 32 * s2 + fq * 4);
          const half4 w1 = *(const half4*)(w2t + (dt * 16 + fr) * 64 + 32 * s2 + 16 + fq * 4);
          const half8 wf = __builtin_shufflevector(w0, w1, 0, 1, 2, 3, 4, 5, 6, 7);
          a2[dt] = MFMA16(wf, gf, a2[dt]);
        }
      }
      if (kv == 0) {
#pragma unroll
        for (int dt = 0; dt < 4; ++dt) {
          half4 o = {(h16)a2[dt][0], (h16)a2[dt][1], (h16)a2[dt][2], (h16)a2[dt][3]};
          *(half4*)(kc + ((size_t)bg * 128 + n) * 64 + dt * 16 + fq * 4) = o;
        }
      } else {
#pragma unroll
        for (int dt = 0; dt < 4; ++dt)
#pragma unroll
          for (int j = 0; j < 4; ++j) vcT[((size_t)bg * 64 + dt * 16 + fq * 4 + j) * 128 + n] = (h16)a2[dt][j];
      }
    }
  }
  {
    const float* cw = p.conv_w + (size_t)l * 3 * 256;
    const int c8 = (tid & 31) * 8;
    float w0[8], w1[8], w2[8];
#pragma unroll
    for (int j = 0; j < 8; ++j) { w0[j] = cw[c8 + j]; w1[j] = cw[256 + c8 + j]; w2[j] = cw[512 + c8 + j]; }
    for (int row = blockIdx.x * 16 + (tid >> 5); row < MTOK; row += gridDim.x * 16) {
      const int t = row & (SEQ - 1);
      const h16* hr = h + (size_t)row * LDH;
      const half8 bgv = *(const half8*)(hr + C_BG + c8);
      const half8 c0 = *(const half8*)(hr + C_CG + c8), x0 = *(const half8*)(hr + C_XC + c8);
      half8 c1 = c0, x1 = x0, c2 = c0, x2 = x0;
      if (t >= 1) { c1 = *(const half8*)(hr - LDH + C_CG + c8); x1 = *(const half8*)(hr - LDH + C_XC + c8); }
      if (t >= 2) { c2 = *(const half8*)(hr - 2 * LDH + C_CG + c8); x2 = *(const half8*)(hr - 2 * LDH + C_XC + c8); }
      half8 o;
#pragma unroll
      for (int j = 0; j < 8; ++j) {
        const float u0 = (float)c0[j] * (float)x0[j];
        const float u1 = t >= 1 ? (float)c1[j] * (float)x1[j] : 0.f;
        const float u2 = t >= 2 ? (float)c2[j] * (float)x2[j] : 0.f;
        o[j] = (h16)((float)bgv[j] * (w0[j] * u2 + w1[j] * u1 + w2[j] * u0));
      }
      *(half8*)(mix + (size_t)row * 1024 + c8) = o;
    }
  }
  {
    float* u = (float*)smem;
    float* dd = (float*)smem + 47 * 256;
    const float* pw = p.pool_w + (size_t)l * 4 * 64 * 64;
    const float* psc = p.pool_scale + (size_t)l * 256;
    for (int tile = blockIdx.x; tile < MTOK / 32; tile += gridDim.x) {
      const int row0 = tile * 32, t0 = row0 & (SEQ - 1);
      for (int e = tid; e < 47 * 32; e += 512) {
        const int rr = e >> 5, ch = (e & 31) * 8, t = t0 - 15 + rr;
        half8 v;
#pragma unroll
        for (int j = 0; j < 8; ++j) v[j] = (h16)0.f;
        if (t >= 0) v = *(const half8*)(h + (size_t)(row0 - 15 + rr) * LDH + C_XP + ch);
#pragma unroll
        for (int j = 0; j < 8; ++j) u[rr * 256 + ch + j] = (float)v[j];
      }
      __syncthreads();
      {
        const int c = tid & 255, gi = c >> 6, w = 2 << gi;
#pragma unroll 4
        for (int i = 0; i < 16; ++i) {
          const int tok = (tid >> 8) + 2 * i, t = t0 + tok;
          const int cnt = (t + 1) < w ? (t + 1) : w;
          float s = 0.f;
          for (int k = 0; k < cnt; ++k) s += u[(15 + tok - k) * 256 + c];
          dd[tok * 256 + c] = s / (float)cnt - u[(15 + tok) * 256 + c];
        }
      }
      __syncthreads();
      {
        const int dg = tid & 255, gi = dg >> 6, dcol = dg & 63, tp = tid >> 8;
        float acc[16];
#pragma unroll
        for (int i = 0; i < 16; ++i) acc[i] = 0.f;
        for (int c = 0; c < 64; ++c) {
          const float wv = pw[(gi * 64 + c) * 64 + dcol];
#pragma unroll
          for (int i = 0; i < 16; ++i) acc[i] += dd[(tp + 2 * i) * 256 + gi * 64 + c] * wv;
        }
        const float sc = psc[dg];
#pragma unroll
        for (int i = 0; i < 16; ++i) mix[(size_t)(row0 + tp + 2 * i) * 1024 + 768 + dg] = (h16)(acc[i] * sc);
      }
      __syncthreads();
    }
  }
  {
    h16* tl = (h16*)smem;
    for (int task = blockIdx.x; task < 4096; task += gridDim.x) {
      const int ts = task >> 11, rem = task & 2047, bg = rem >> 5, tt = rem & 31, b = bg >> 1, g = bg & 1;
      const h16* src = h + ((size_t)b * SEQ + tt * 64) * LDH + (ts ? C_VW : C_VS) + g * 64;
      h16* dst = (h16*)(p.ws + (ts ? OFF_VWT : OFF_VST)) + (size_t)bg * 64 * SEQ + tt * 64;
      { const int tk = tid >> 3, ch = tid & 7; *(half8*)(tl + tk * 72 + ch * 8) = *(const half8*)(src + (size_t)tk * LDH + ch * 8); }
      __syncthreads();
      { const int d = tid >> 3, tch = tid & 7; half8 o;
#pragma unroll
        for (int j = 0; j < 8; ++j) o[j] = tl[(tch * 8 + j) * 72 + d];
        *(half8*)(dst + (size_t)d * SEQ + tch * 8) = o; }
      __syncthreads();
    }
  }
}

DI float red4_max(float v) { v = fmaxf(v, __shfl_xor(v, 16)); v = fmaxf(v, __shfl_xor(v, 32)); return v; }
DI float red4_sum(float v) { v += __shfl_xor(v, 16); v += __shfl_xor(v, 32); return v; }

template <int MODE, bool FAR>
DI void attn_step(const h16* __restrict__ kbase, const h16* __restrict__ vT, const int kb, const int t, const int fr, const int fq, const bool selbit,
                  const float* tabh  , const float (&tabc)[2], const half8 (&q)[2][2], f32x4 (&O)[2][4], float (&m)[2], float (&l)[2]) {
  half8 kf[2][2];
#pragma unroll
  for (int kt = 0; kt < 2; ++kt)
#pragma unroll
    for (int ks = 0; ks < 2; ++ks) kf[kt][ks] = *(const half8*)(kbase + (size_t)(kb + kt * 16 + fr) * LDH + ks * 32 + fq * 8);
  half4 vv[4][2];
#pragma unroll
  for (int dt = 0; dt < 4; ++dt) {
    vv[dt][0] = *(const half4*)(vT + (size_t)(dt * 16 + fr) * SEQ + kb + fq * 4);
    vv[dt][1] = *(const half4*)(vT + (size_t)(dt * 16 + fr) * SEQ + kb + 16 + fq * 4);
  }
  bool valid[2][4]; int idx[2][4];
#pragma unroll
  for (int kt = 0; kt < 2; ++kt)
#pragma unroll
    for (int j = 0; j < 4; ++j) {
      const int dist = t - (kb + kt * 16 + fq * 4 + j);
      valid[kt][j] = (dist >= 0) && (MODE == 1 ? selbit : (dist < 512));
      idx[kt][j] = dist < 0 ? 0 : (dist > 128 ? 128 : dist);
    }
  half8 pf[2];
#pragma unroll
  for (int hp = 0; hp < 2; ++hp) {
    f32x4 s[2];
#pragma unroll
    for (int kt = 0; kt < 2; ++kt) {
      s[kt] = MFMA16(kf[kt][0], q[hp][0], ((f32x4){0.f, 0.f, 0.f, 0.f}));
      s[kt] = MFMA16(kf[kt][1], q[hp][1], s[kt]);
    }
    float mx = m[hp];
#pragma unroll
    for (int kt = 0; kt < 2; ++kt)
#pragma unroll
      for (int j = 0; j < 4; ++j) {
        float bias;
        if (FAR) bias = tabc[hp]; else bias = tabh[hp * 132 + idx[kt][j]];
        const float sv = s[kt][j] + bias;
        const float v = valid[kt][j] ? sv : NEGF;
        s[kt][j] = v; mx = fmaxf(mx, v);
      }
    mx = red4_max(mx);
    const float alpha = __expf(m[hp] - mx);
    float ps = 0.f;
#pragma unroll
    for (int kt = 0; kt < 2; ++kt)
#pragma unroll
      for (int j = 0; j < 4; ++j) { const float pv = s[kt][j] > -1e29f ? __expf(s[kt][j] - mx) : 0.f; ps += pv; s[kt][j] = pv; }
    ps = red4_sum(ps);
    l[hp] = l[hp] * alpha + ps; m[hp] = mx;
#pragma unroll
    for (int dt = 0; dt < 4; ++dt) O[hp][dt] = O[hp][dt] * alpha;
    pf[hp] = (half8){(h16)s[0][0], (h16)s[0][1], (h16)s[0][2], (h16)s[0][3], (h16)s[1][0], (h16)s[1][1], (h16)s[1][2], (h16)s[1][3]};
  }
#pragma unroll
  for (int dt = 0; dt < 4; ++dt) {
    const half8 vf = __builtin_shufflevector(vv[dt][0], vv[dt][1], 0, 1, 2, 3, 4, 5, 6, 7);
#pragma unroll
    for (int hp = 0; hp < 2; ++hp) O[hp][dt] = MFMA16(vf, pf[hp], O[hp][dt]);
  }
}

DI void attn_phase(const Params& p) {
  const int tid = opaque_tid(), wave = tid >> 6, lane = tid & 63, fr = lane & 15, fq = lane >> 4;
  float* tab = (float*)smem;
  float* impb = (float*)(smem + 4224) + wave * 576;
  float* impx = (float*)(smem + 4224 + 18432);
  float* fin = (float*)(smem + 4224 + 18432 + 16384) + wave * 2048;
  {
    const float* tg = (const float*)(p.ws + OFF_TAB);
    for (int i = tid; i < 8 * 132; i += 512) tab[i] = tg[i];
  }
  __syncthreads();
  const h16* h = (const h16*)(p.ws + OFF_H);
  h16* mix = (h16*)(p.ws + OFF_MIX);
  const int nunits = BATCH * 2 * 32;
  const int hpair = wave >> 2;
  for (int it = 0; it * (int)gridDim.x < nunits; ++it) {
    const int uid = it * (int)gridDim.x + (int)blockIdx.x;
    const bool active = uid < nunits;
    int bg, q0;
    if (gridDim.x == 256) { bg = it * 8 + ((int)blockIdx.x & 7); q0 = (int)blockIdx.x >> 3; } else { bg = uid >> 5; q0 = uid & 31; }
    if (!active) { bg = 0; q0 = 0; }
    const int qblk = (it & 1) ? 31 - q0 : q0;
    const int b = bg >> 1, g = bg & 1;
    const int t0 = qblk * 64 + (wave & 3) * 16, t = t0 + fr, cur = qblk;
    const int hh0 = g * 4 + hpair * 2;
    const h16* hb = h + (size_t)b * SEQ * LDH;
    const float* tabh = tab + hh0 * 132;
    float tabc[2];
#pragma unroll
    for (int hp = 0; hp < 2; ++hp) tabc[hp] = tabh[hp * 132 + 128];
    half8 q[2][2];
#pragma unroll
    for (int hp = 0; hp < 2; ++hp)
#pragma unroll
      for (int ks = 0; ks < 2; ++ks) {
        half8 qq = *(const half8*)(hb + (size_t)t * LDH + C_Q + (hh0 + hp) * 64 + ks * 32 + fq * 8);
        q[hp][ks] = qq * (h16)0.125f;
      }
    float gate[2][3];
#pragma unroll
    for (int hp = 0; hp < 2; ++hp)
#pragma unroll
      for (int br = 0; br < 3; ++br) {
        const float gl = (float)hb[(size_t)t * LDH + C_GL + (hh0 + hp) * 3 + br];
        gate[hp][br] = 1.f / (1.f + __expf(-gl));
      }
    unsigned selmask;
    {
      const h16* kcb = (const h16*)(p.ws + OFF_KC) + (size_t)bg * 128 * 64;
      const h16* vcb = (const h16*)(p.ws + OFF_VCT) + (size_t)bg * 64 * 128;
      float impv[8];
#pragma unroll
      for (int nt = 0; nt < 8; ++nt) impv[nt] = 0.f;
#pragma unroll
      for (int hp = 0; hp < 2; ++hp) {
        f32x4 s[8];
#pragma unroll
        for (int nt = 0; nt < 8; ++nt) {
          const half8 k0 = *(const half8*)(kcb + (nt * 16 + fr) * 64 + fq * 8);
          const half8 k1 = *(const half8*)(kcb + (nt * 16 + fr) * 64 + 32 + fq * 8);
          s[nt] = MFMA16(k0, q[hp][0], ((f32x4){0.f, 0.f, 0.f, 0.f}));
          s[nt] = MFMA16(k1, q[hp][1], s[nt]);
        }
        float mx = NEGF;
#pragma unroll
        for (int nt = 0; nt < 8; ++nt)
#pragma unroll
          for (int j = 0; j < 4; ++j) {
            const int n = nt * 16 + fq * 4 + j, dist = t - 16 * n - 31;
            const int ix = dist < 0 ? 0 : (dist > 128 ? 128 : dist);
            const float bv = tabh[hp * 132 + ix];
            const float sv = s[nt][j] + bv;
            const float vv = dist >= 0 ? sv : NEGF;
            s[nt][j] = vv; mx = fmaxf(mx, vv);
          }
        mx = red4_max(mx);
        float ps = 0.f;
#pragma unroll
        for (int nt = 0; nt < 8; ++nt)
#pragma unroll
          for (int j = 0; j < 4; ++j) { const float pv = s[nt][j] > -1e29f ? __expf(s[nt][j] - mx) : 0.f; ps += pv; s[nt][j] = pv; }
        ps = red4_sum(ps);
        const float inv = ps > 0.f ? 1.f / ps : 0.f;
#pragma unroll
        for (int nt = 0; nt < 8; ++nt) s[nt] = s[nt] * inv;
#pragma unroll
        for (int nt = 0; nt < 8; ++nt) {
          const float x1 = __shfl(s[nt][3], (lane - 16) & 63);
          const float x2 = nt > 0 ? __shfl(s[nt > 0 ? nt - 1 : 0][3], (lane - 16) & 63) : 0.f;
          const float left = fq > 0 ? x1 : x2;
          impv[nt] += left + 2.f * (s[nt][0] + s[nt][1] + s[nt][2]) + s[nt][3];
        }
        f32x4 o[4];
#pragma unroll
        for (int dt = 0; dt < 4; ++dt) o[dt] = (f32x4){0.f, 0.f, 0.f, 0.f};
#pragma unroll
        for (int st = 0; st < 4; ++st) {
          const half8 pf = {(h16)s[2 * st][0], (h16)s[2 * st][1], (h16)s[2 * st][2], (h16)s[2 * st][3],
                            (h16)s[2 * st + 1][0], (h16)s[2 * st + 1][1], (h16)s[2 * st + 1][2], (h16)s[2 * st + 1][3]};
#pragma unroll
          for (int dt = 0; dt < 4; ++dt) {
            const half4 v0 = *(const half4*)(vcb + (dt * 16 + fr) * 128 + st * 32 + fq * 4);
            const half4 v1 = *(const half4*)(vcb + (dt * 16 + fr) * 128 + st * 32 + 16 + fq * 4);
            const half8 vf = __builtin_shufflevector(v0, v1, 0, 1, 2, 3, 4, 5, 6, 7);
            o[dt] = MFMA16(vf, pf, o[dt]);
          }
        }
#pragma unroll
        for (int dt = 0; dt < 4; ++dt)
#pragma unroll
          for (int j = 0; j < 4; ++j) fin[(hp * 16 + dt * 4 + j) * 64 + lane] = o[dt][j] * gate[hp][0];
        __builtin_amdgcn_sched_barrier(0);
      }
#pragma unroll
      for (int nt = 0; nt < 8; ++nt) impx[(wave * 8 + nt) * 64 + lane] = impv[nt];
      __syncthreads();
#pragma unroll
      for (int nt = 0; nt < 8; ++nt) {
        const float other = impx[((wave ^ 4) * 8 + nt) * 64 + lane];
        const float im = hpair == 0 ? impv[nt] + other : other + impv[nt];
        const int jb = nt * 4 + fq;
        const bool forced = (jb == 0) || (jb == cur) || (jb == cur - 1);
        impv[nt] = jb <= cur ? im + (forced ? 1e6f : 0.f) : NEGF;
        impb[fr * 36 + jb] = impv[nt];
      }
      __syncthreads();
      int cnt[8];
#pragma unroll
      for (int nt = 0; nt < 8; ++nt) cnt[nt] = 0;
#pragma unroll
      for (int i = 0; i < 8; ++i) {
        const float4 r4 = *(const float4*)(impb + fr * 36 + 4 * i);
        const float rv[4] = {r4.x, r4.y, r4.z, r4.w};
#pragma unroll
        for (int nt = 0; nt < 8; ++nt) {
          const float a = impv[nt]; const int ja = nt * 4 + fq;
#pragma unroll
          for (int c = 0; c < 4; ++c) cnt[nt] += (int)(rv[c] > a) | ((int)(rv[c] == a) & (int)((4 * i + c) < ja));
        }
      }
      unsigned mk = 0;
#pragma unroll
      for (int nt = 0; nt < 8; ++nt) { const int ja = nt * 4 + fq; if (cnt[nt] < 8 && ja <= cur) mk |= 1u << ja; }
      mk |= (unsigned)__shfl_xor((int)mk, 16);
      mk |= (unsigned)__shfl_xor((int)mk, 32);
      selmask = mk;
    }
    if (!active) continue;
    {
      f32x4 O[2][4]; float m[2], l[2];
#pragma unroll
      for (int hp = 0; hp < 2; ++hp) { m[hp] = NEGF; l[hp] = 0.f;
#pragma unroll
        for (int dt = 0; dt < 4; ++dt) O[hp][dt] = (f32x4){0.f, 0.f, 0.f, 0.f}; }
      const h16* kbase = hb + C_KS + g * 64;
      const h16* vT = (const h16*)(p.ws + OFF_VST) + (size_t)bg * 64 * SEQ;
      for (int j = 0; j <= cur; ++j) {
        const bool bit = (selmask >> j) & 1u;
        if (__ballot(bit) == 0ull) continue;
#pragma unroll 1
        for (int hf = 0; hf < 2; ++hf) {
          const int kb = j * 64 + hf * 32;
          if (kb > t0 + 15) continue;
          const bool far = (kb + 31 + 128 <= t0);
          if (far) attn_step<1, true>(kbase, vT, kb, t, fr, fq, bit, tabh, tabc, q, O, m, l);
          else attn_step<1, false>(kbase, vT, kb, t, fr, fq, bit, tabh, tabc, q, O, m, l);
        }
      }
#pragma unroll
      for (int hp = 0; hp < 2; ++hp) {
        const float sc = l[hp] > 0.f ? gate[hp][1] / l[hp] : 0.f;
#pragma unroll
        for (int dt = 0; dt < 4; ++dt)
#pragma unroll
          for (int j = 0; j < 4; ++j) fin[(hp * 16 + dt * 4 + j) * 64 + lane] += O[hp][dt][j] * sc;
      }
    }
    {
      f32x4 O[2][4]; float m[2], l[2];
#pragma unroll
      for (int hp = 0; hp < 2; ++hp) { m[hp] = NEGF; l[hp] = 0.f;
#pragma unroll
        for (int dt = 0; dt < 4; ++dt) O[hp][dt] = (f32x4){0.f, 0.f, 0.f, 0.f}; }
      const h16* kbase = hb + C_KW + g * 64;
      const h16* vT = (const h16*)(p.ws + OFF_VWT) + (size_t)bg * 64 * SEQ;
      int lo = t0 - 511; if (lo < 0) lo = 0; lo &= ~31;
#pragma unroll 1
      for (int kb = lo; kb <= t0 + 15; kb += 32) {
        const bool far = (kb + 31 + 128 <= t0);
        if (far) attn_step<2, true>(kbase, vT, kb, t, fr, fq, true, tabh, tabc, q, O, m, l);
        else attn_step<2, false>(kbase, vT, kb, t, fr, fq, true, tabh, tabc, q, O, m, l);
      }
#pragma unroll
      for (int hp = 0; hp < 2; ++hp) {
        const float sc = l[hp] > 0.f ? gate[hp][2] / l[hp] : 0.f;
#pragma unroll
        for (int dt = 0; dt < 4; ++dt) {
          half4 o;
#pragma unroll
          for (int j = 0; j < 4; ++j) o[j] = (h16)(fin[(hp * 16 + dt * 4 + j) * 64 + lane] + O[hp][dt][j] * sc);
          *(half4*)(mix + ((size_t)b * SEQ + t) * 1024 + 256 + (hh0 + hp) * 64 + dt * 16 + fq * 4) = o;
        }
      }
    }
  }
}

__global__ void __launch_bounds__(512) hymba_fwd(const Params p) {
  cg::grid_group grid = cg::this_grid();
  unsigned char* ws = p.ws;
  for (int ph = p.phase_lo; ph < p.phase_hi; ++ph) {
    if (ph > p.phase_lo) grid.sync();
    if (ph == 0) { prologue(p); continue; }
    const int l = (ph - 1) >> 3, s = (ph - 1) & 7;
    h16* xa = (h16*)(ws + OFF_XA); h16* mix = (h16*)(ws + OFF_MIX); h16* y = (h16*)(ws + OFF_Y); h16* hbuf = (h16*)(ws + OFF_H);
    if (s == 0) { EpiArgs ea{hbuf, nullptr}; gemm_phase<0>(xa, (const h16*)(ws + OFF_WIN + l * SZ_WIN), LDH, 1024, ea); }
    else if (s == 1) mixers_phase(p, l);
    else if (s == 2) attn_phase(p);
    else if (s == 3) { EpiArgs ea{y, xa}; gemm_phase<1>(mix, (const h16*)(ws + OFF_WOUT + l * SZ_WOUT), 1024, 1024, ea); }
    else if (s == 4) ln_phase(y, p.ln1_g + l * 1024, p.ln1_b + l * 1024, xa, nullptr);
    else if (s == 5) { EpiArgs ea{hbuf, nullptr}; gemm_phase<2>(xa, (const h16*)(ws + OFF_WGU + l * SZ_WGU), 5632, 1024, ea); }
    else if (s == 6) { EpiArgs ea{y, xa}; gemm_phase<1>(hbuf, (const h16*)(ws + OFF_WDN + l * SZ_WDN), 1024, DFF, ea); }
    else ln_phase(y, p.ln2_g + l * 1024, p.ln2_b + l * 1024, xa, l == 1 ? p.out : nullptr);
  }
}

#ifndef SINGLE_LAUNCH
#define SINGLE_LAUNCH 0
#endif

extern "C" void kernel_launch(void* const* d_in, const int* in_sizes, int n_in, void* d_out, int out_size, void* d_ws, size_t ws_size, hipStream_t stream) {
  static int grid_blocks = 0;
  if (!grid_blocks) {
    int dev = 0, cus = 0, per_cu = 0;
    hipGetDevice(&dev);
    hipDeviceGetAttribute(&cus, hipDeviceAttributeMultiprocessorCount, dev);
    hipFuncSetAttribute((const void*)hymba_fwd, hipFuncAttributeMaxDynamicSharedMemorySize, LDS_BYTES);
    hipOccupancyMaxActiveBlocksPerMultiprocessor(&per_cu, hymba_fwd, 512, LDS_BYTES);
    if (per_cu < 1) per_cu = 1;
    grid_blocks = cus * per_cu;
    if (ws_size < WS_NEED) fprintf(stderr, "workspace too small: %zu < %zu\n", ws_size, (size_t)WS_NEED);
  }
  Params p{};
  p.x = (const float*)d_in[0]; p.w_in = (const float*)d_in[1]; p.conv_w = (const float*)d_in[2]; p.cmp_pe = (const float*)d_in[3];
  p.cmp_w1 = (const float*)d_in[4]; p.cmp_w2 = (const float*)d_in[5]; p.pool_w = (const float*)d_in[6]; p.pool_scale = (const float*)d_in[7];
  p.w_out = (const float*)d_in[8]; p.ln1_g = (const float*)d_in[9]; p.ln1_b = (const float*)d_in[10]; p.w_gate = (const float*)d_in[11];
  p.w_up = (const float*)d_in[12]; p.w_down = (const float*)d_in[13]; p.ln2_g = (const float*)d_in[14]; p.ln2_b = (const float*)d_in[15];
  p.rel_bias = (const float*)d_in[16];
  p.out = (float*)d_out; p.ws = (unsigned char*)d_ws;
#if SINGLE_LAUNCH
  p.phase_lo = 0; p.phase_hi = NPHASE;
  void* args[] = {&p};
  hipError_t e = hipLaunchCooperativeKernel((const void*)hymba_fwd, dim3(grid_blocks), dim3(512), args, LDS_BYTES, stream);
  if (e != hipSuccess) fprintf(stderr, "cooperative launch failed: %s (grid %d)\n", hipGetErrorString(e), grid_blocks);
#else
  for (int ph = 0; ph < NPHASE; ++ph) {
    p.phase_lo = ph; p.phase_hi = ph + 1;
    hipLaunchKernelGGL(hymba_fwd, dim3(grid_blocks), dim3(512), LDS_BYTES, stream, p);
  }
#endif
}
```

```cpp
#include <hip/hip_runtime.h>
#include <hip/hip_cooperative_groups.h>
#include <cstdio>
#include <cstdint>
namespace cg = cooperative_groups;

typedef _Float16 h16;
typedef _Float16 half8 __attribute__((ext_vector_type(8)));
typedef _Float16 half4 __attribute__((ext_vector_type(4)));
typedef float f32x4 __attribute__((ext_vector_type(4)));
#define DI __device__ __forceinline__
__device__ __forceinline__ int lane_id_hw() { int l; asm volatile("v_mbcnt_lo_u32_b32 %0, -1, 0\n\tv_mbcnt_hi_u32_b32 %0, -1, %0" : "=v"(l)); return l; }
__device__ __forceinline__ int opaque_tid(int wid_s) { int t = wid_s * 64 + lane_id_hw(); asm volatile("" : "+v"(t)); return t; }
#define MFMA16(a, b, c) __builtin_amdgcn_mfma_f32_16x16x32_f16((a), (b), (c), 0, 0, 0)

DI float lane_get(float v, int srclane) { return __int_as_float(__builtin_amdgcn_ds_bpermute(srclane << 2, __float_as_int(v))); }
DI int lane_get_i(int v, int srclane) { return __builtin_amdgcn_ds_bpermute(srclane << 2, v); }
constexpr int SEQ = 2048, BATCH = 32, MTOK = BATCH * SEQ, DM = 1024, DIN = 2328, LDH = 2560, DFF = 2816;
constexpr int C_BG = 0, C_CG = 256, C_XC = 512, C_Q = 768, C_KC = 1280, C_VC = 1408, C_KS = 1536, C_VS = 1664, C_KW = 1792, C_VW = 1920, C_GL = 2048, C_XP = 2072;
constexpr float ALPHA_F = 1.41421356237309515f;
constexpr float NEGF = -1e30f;
constexpr int NPHASE = 17;

constexpr size_t SZ_WIN = (size_t)LDH * 1024 * 2, SZ_WOUT = (size_t)1024 * 1024 * 2, SZ_WGU = (size_t)5632 * 1024 * 2, SZ_WDN = (size_t)1024 * DFF * 2;
constexpr size_t OFF_WIN = 0;
constexpr size_t OFF_WOUT = OFF_WIN + 2 * SZ_WIN;
constexpr size_t OFF_WGU = OFF_WOUT + 2 * SZ_WOUT;
constexpr size_t OFF_WDN = OFF_WGU + 2 * SZ_WGU;
constexpr size_t OFF_W1T = OFF_WDN + 2 * SZ_WDN;
constexpr size_t OFF_W2T = OFF_W1T + 4 * 64 * 2048 * 2;
constexpr size_t OFF_PE = OFF_W2T + 4 * 64 * 64 * 2;
constexpr size_t OFF_TAB = OFF_PE + 4 * 32 * 64 * 2;
constexpr size_t OFF_KC = OFF_TAB + 8192;
constexpr size_t OFF_VCT = OFF_KC + 64 * 128 * 64 * 2;
constexpr size_t OFF_VST = OFF_VCT + 64 * 128 * 64 * 2;
constexpr size_t OFF_VWT = OFF_VST + (size_t)64 * 64 * 2048 * 2;
constexpr size_t OFF_XA = OFF_VWT + (size_t)64 * 64 * 2048 * 2;
constexpr size_t OFF_MIX = OFF_XA + (size_t)MTOK * 1024 * 2;
constexpr size_t OFF_Y = OFF_MIX + (size_t)MTOK * 1024 * 2;
constexpr size_t OFF_H = OFF_Y + (size_t)MTOK * 1024 * 2;
constexpr size_t OFF_BAR = OFF_H + (size_t)MTOK * DFF * 2;
constexpr size_t OFF_KMAX = OFF_BAR + 14336;
constexpr size_t WS_NEED = OFF_BAR + 16384;

constexpr int LDS_BYTES = 131072 + 16;

struct Params {
  const float *x, *w_in, *conv_w, *cmp_pe, *cmp_w1, *cmp_w2, *pool_w, *pool_scale, *w_out, *ln1_g, *ln1_b, *w_gate, *w_up, *w_down, *ln2_g, *ln2_b, *rel_bias;
  float* out;
  unsigned char* ws;
  int phase_lo, phase_hi, probe_mask, use_cg;
};

extern __shared__ __attribute__((aligned(16))) unsigned char smem[];
#define LAS_ __attribute__((address_space(3)))
__device__ __forceinline__ int vbid() { return __builtin_amdgcn_readfirstlane((int)((volatile LAS_ unsigned*)((LAS_ unsigned char*)smem + 131072))[3]); }

constexpr int BK = 64, HALF = 128, HT = HALF * BK;
DI int lds_byte(int r, int c) { int st = (r >> 4) * 2 + (c >> 5), rr = r & 15, cc = c & 31, ob = rr * 64 + cc * 2; return st * 1024 + (ob ^ (((ob >> 9) & 1) << 5)); }
DI void stage_rc(int b, int& R, int& C) { int st = b / 1024, sb = b % 1024, swz = sb ^ (((sb >> 9) & 1) << 5); R = (st >> 1) * 16 + swz / 64; C = (st & 1) * 32 + (swz % 64) / 2; }

struct EpiArgs { h16* out; const h16* res; };

#define LAS __attribute__((address_space(3)))
DI int perm32(int rho) { const int n = rho >> 4, i = rho & 15; return 8 * (i >> 2) + 4 * n + (i & 3); }

template <int EPI>
DI void gemm_phase(const int wid_s, const h16* __restrict__ A, const h16* __restrict__ Bt, const int N, const int K, const EpiArgs ea) {
  LAS unsigned char* lds = (LAS unsigned char*)smem;
  const int tid = opaque_tid(wid_s), wid = __builtin_amdgcn_readfirstlane(tid >> 6), lane = tid & 63, wr = wid >> 2, wc = wid & 3, fr = lane & 15, fq = lane >> 4;
  unsigned voffA[2], voffB[2];
#pragma unroll
  for (int i = 0; i < 2; ++i) { int R, C; stage_rc(tid * 16 + i * 8192, R, C); const int Rb = (R & ~31) + perm32(R & 31);
    voffA[i] = (unsigned)(R * K + C) * 2u; voffB[i] = (unsigned)(Rb * K + C) * 2u; }
  const size_t kstep = (size_t)(BK * 2), hstep = (size_t)HALF * K * 2;
  const unsigned ldsw = (unsigned)wid * 1024u;
  const int aoff = lds_byte(wr * 64 + fr, fq * 8), boff = lds_byte(wc * 32 + fr, fq * 8);
  constexpr int HTB = HT * 2;
#define SA(b, h) (((b) * 2 + (h)) * HTB)
#define SB(b, h) ((4 + (b) * 2 + (h)) * HTB)
#define STAGE(bufoff, gbase, voff) do { _Pragma("unroll") for (int _i = 0; _i < 2; ++_i) \
    __builtin_amdgcn_global_load_lds((const unsigned*)((const char*)(gbase) + (voff)[_i]), (LAS unsigned*)(lds + (bufoff) + ldsw + _i * 8192), 16, 0, 0); } while (0)
#define LDA(dst, b, h) do { _Pragma("unroll") for (int m = 0; m < 4; ++m) _Pragma("unroll") for (int k = 0; k < 2; ++k) dst[m][k] = *(const LAS half8*)(lds + SA(b, h) + aoff + m * 2048 + k * 1024); } while (0)
#define LDB(dst, b, h) do { _Pragma("unroll") for (int n = 0; n < 2; ++n) _Pragma("unroll") for (int k = 0; k < 2; ++k) dst[n][k] = *(const LAS half8*)(lds + SB(b, h) + boff + n * 2048 + k * 1024); } while (0)
#define MMA(ai, bj, At_, Bt_) do { __builtin_amdgcn_s_setprio(1); \
    _Pragma("unroll") for (int m = 0; m < 4; ++m) _Pragma("unroll") for (int n = 0; n < 2; ++n) _Pragma("unroll") for (int k = 0; k < 2; ++k) \
      acc[ai][bj][m][n] = MFMA16(Bt_[n][k], At_[m][k], acc[ai][bj][m][n]); \
    __builtin_amdgcn_s_setprio(0); } while (0)
#define WAIT_V(n) asm volatile("s_waitcnt vmcnt(" #n ")" ::: "memory")
#define WAIT_L(n) asm volatile("s_waitcnt lgkmcnt(" #n ")" ::: "memory")
#define BAR __builtin_amdgcn_s_barrier()
#define SCHED __builtin_amdgcn_sched_barrier(0)
#define TILE_RC(L_, brow_, bcol_) do { int wgid = (L_); \
    { const int q = nwg / 8, r = nwg % 8, xcd = wgid % 8, off = wgid / 8; wgid = (xcd < r ? xcd * (q + 1) : r * (q + 1) + (xcd - r) * q) + off; } \
    const int nig = 4 * nN, gid = wgid / nig, fm = gid * 4, gsz = (nM - fm) < 4 ? (nM - fm) : 4; \
    brow_ = (fm + ((wgid % nig) % gsz)) * 256; bcol_ = ((wgid % nig) / gsz) * 256; } while (0)
  const int nM = MTOK / 256, nN = N / 256, nwg = nM * nN;
  const int nt = K / BK;
  int L = vbid();
  if (L >= nwg) return;
  int brow, bcol;
  TILE_RC(L, brow, bcol);
  const char* cA = (const char*)A + (size_t)brow * K * 2;
  const char* cB = (const char*)Bt + (size_t)bcol * K * 2;
  f32x4 acc[2][2][4][2];
#pragma unroll
  for (int a = 0; a < 2; ++a)
#pragma unroll
    for (int b = 0; b < 2; ++b)
#pragma unroll
      for (int m = 0; m < 4; ++m)
#pragma unroll
        for (int n = 0; n < 2; ++n) acc[a][b][m][n] = (f32x4){0.f, 0.f, 0.f, 0.f};
  half8 At[4][2], B0[2][2], B1[2][2];
  STAGE(SB(0, 0), cB, voffB); STAGE(SB(0, 1), cB + hstep, voffB); STAGE(SA(0, 0), cA, voffA); STAGE(SA(0, 1), cA + hstep, voffA);
  if (wr == 1) BAR;
  WAIT_V(2); BAR;
  STAGE(SB(1, 0), cB + kstep, voffB); STAGE(SA(1, 0), cA + kstep, voffA); STAGE(SB(1, 1), cB + hstep + kstep, voffB);
  WAIT_V(6); BAR;
  for (;;) {
    const int Ln = L + (int)gridDim.x;
    const bool has_next = Ln < nwg;
    int nbrow = brow, nbcol = bcol;
    if (has_next) TILE_RC(Ln, nbrow, nbcol);
    const char* nA = (const char*)A + (size_t)nbrow * K * 2;
    const char* nB = (const char*)Bt + (size_t)nbcol * K * 2;
    for (int t = 0; t < nt; t += 2) {
      const bool last = (t == nt - 2);
      const char* a1 = cA + (size_t)(t + 1) * kstep;
      const char* a2 = last ? nA : cA + (size_t)(t + 2) * kstep; const char* b2 = last ? nB : cB + (size_t)(t + 2) * kstep;
      const char* a3 = a2 + kstep; const char* b3 = b2 + kstep;
      LDB(B0, 0, 0); LDB(B1, 0, 1); SCHED; LDA(At, 0, 0); STAGE(SA(1, 1), a1 + hstep, voffA);
      WAIT_V(8); WAIT_L(0); BAR; MMA(0, 0, At, B0); MMA(0, 1, At, B1); BAR; SCHED;
      LDA(At, 0, 1); STAGE(SB(0, 0), b2, voffB); STAGE(SB(0, 1), b2 + hstep, voffB); STAGE(SA(0, 0), a2, voffA);
      WAIT_V(8); WAIT_L(0); BAR; MMA(1, 0, At, B0); MMA(1, 1, At, B1); BAR; SCHED;
      LDB(B0, 1, 0); LDB(B1, 1, 1); SCHED; LDA(At, 1, 0); STAGE(SA(0, 1), a2 + hstep, voffA);
      WAIT_V(8); WAIT_L(0); BAR; MMA(0, 0, At, B0); MMA(0, 1, At, B1); BAR; SCHED;
      LDA(At, 1, 1); STAGE(SB(1, 0), b3, voffB); STAGE(SB(1, 1), b3 + hstep, voffB); STAGE(SA(1, 0), a3, voffA);
      WAIT_V(8); WAIT_L(0); BAR; MMA(1, 0, At, B0); MMA(1, 1, At, B1); BAR; SCHED;
    }
    if (wr == 0) BAR;
#pragma unroll
    for (int ai = 0; ai < 2; ++ai)
#pragma unroll
      for (int m = 0; m < 4; ++m) {
        const size_t row = (size_t)(brow + ai * HALF + wr * 64 + m * 16 + fr);
#pragma unroll
        for (int bj = 0; bj < 2; ++bj) {
          const int col0 = bcol + bj * HALF + wc * 32 + 8 * fq;
          const f32x4 v0 = acc[ai][bj][m][0], v1 = acc[ai][bj][m][1];
          if (EPI == 0) {
            half8 o = {(h16)v0[0], (h16)v0[1], (h16)v0[2], (h16)v0[3], (h16)v1[0], (h16)v1[1], (h16)v1[2], (h16)v1[3]};
            *(half8*)(ea.out + row * LDH + col0) = o;
          } else if (EPI == 1) {
            const half8 r = __builtin_nontemporal_load((const half8*)(ea.res + row * 1024 + col0));
            half8 o;
#pragma unroll
            for (int j = 0; j < 4; ++j) { o[j] = (h16)(ALPHA_F * (float)r[j] + v0[j]); o[4 + j] = (h16)(ALPHA_F * (float)r[4 + j] + v1[j]); }
            *(half8*)(ea.out + row * 1024 + col0) = o;
          } else {
            const int f0 = (bcol + bj * HALF + wc * 32) / 2 + 4 * fq;
            half4 o;
#pragma unroll
            for (int j = 0; j < 4; ++j) { const float g = v0[j], u = v1[j]; o[j] = (h16)(g * __builtin_amdgcn_rcpf(1.f + __builtin_amdgcn_exp2f(g * -1.4426950408889634f)) * u); }
            *(half4*)(ea.out + row * DFF + f0) = o;
          }
        }
        SCHED;
      }
    if (!has_next) break;
#pragma unroll
    for (int a = 0; a < 2; ++a)
#pragma unroll
      for (int b = 0; b < 2; ++b)
#pragma unroll
        for (int m = 0; m < 4; ++m)
#pragma unroll
          for (int n = 0; n < 2; ++n) acc[a][b][m][n] = (f32x4){0.f, 0.f, 0.f, 0.f};
    L = Ln; brow = nbrow; bcol = nbcol; cA = nA; cB = nB;
    if (wr == 1) BAR;
  }
  WAIT_V(0);
  BAR;
#undef SA
#undef SB
#undef STAGE
#undef LDA
#undef LDB
#undef MMA
#undef TILE_RC
}

DI float4 ntld4(const float* p) { const f32x4 v = __builtin_nontemporal_load((const f32x4*)p); return make_float4(v[0], v[1], v[2], v[3]); }
DI int t5_bucket(int n) {
  if (n < 16) return n;
  int v = 16 + (int)(logf((float)n / 16.f) / 2.0794415416798357f * 16.f);
  return v > 31 ? 31 : v;
}

DI void prologue(const Params& p, const int wid_s) {
  const int tid = opaque_tid(wid_s);
  {
    const size_t n8 = (size_t)MTOK * 1024 / 8;
    half8* xa = (half8*)(p.ws + OFF_XA);
    const float4* xs = (const float4*)p.x;
    for (size_t i = (size_t)blockIdx.x * 512 + tid; i < n8; i += (size_t)gridDim.x * 512) {
      const f32x4 a = __builtin_nontemporal_load((const f32x4*)xs + 2 * i), b = __builtin_nontemporal_load((const f32x4*)xs + 2 * i + 1);
      half8 v = {(h16)a[0], (h16)a[1], (h16)a[2], (h16)a[3], (h16)b[0], (h16)b[1], (h16)b[2], (h16)b[3]};
      xa[i] = v;
    }
  }
  {
    const int wave = tid >> 6, lane = tid & 63;
    h16* tile = (h16*)smem + wave * (64 * 66);
    constexpr int PER_LAYER = 3074;
    for (int task = blockIdx.x * 8 + wave; task < 2 * PER_LAYER; task += gridDim.x * 8) {
      const int l = task / PER_LAYER; int r = task % PER_LAYER;
      const float* src0; const float* src1 = nullptr; int ld, K, kind, ntk; h16* dst;
      if (r < 640) { kind = 0; src0 = p.w_in + (size_t)l * 1024 * DIN; ld = DIN; K = 1024; dst = (h16*)(p.ws + OFF_WIN + l * SZ_WIN); }
      else if (r < 896) { r -= 640; kind = 1; src0 = p.w_out + (size_t)l * 1024 * 1024; ld = 1024; K = 1024; dst = (h16*)(p.ws + OFF_WOUT + l * SZ_WOUT); }
      else if (r < 2304) { r -= 896; kind = 2; src0 = p.w_gate + (size_t)l * 1024 * DFF; src1 = p.w_up + (size_t)l * 1024 * DFF; ld = DFF; K = 1024; dst = (h16*)(p.ws + OFF_WGU + l * SZ_WGU); }
      else if (r < 3008) { r -= 2304; kind = 1; src0 = p.w_down + (size_t)l * DFF * 1024; ld = 1024; K = DFF; dst = (h16*)(p.ws + OFF_WDN + l * SZ_WDN); }
      else if (r < 3072) { r -= 3008; const int kv = r / 32; r = r % 32; kind = 1; src0 = p.cmp_w1 + (size_t)(l * 2 + kv) * 2048 * 64; ld = 64; K = 2048; dst = (h16*)(p.ws + OFF_W1T) + (size_t)(l * 2 + kv) * 64 * 2048; }
      else { r -= 3072; const int kv = r; r = 0; kind = 1; src0 = p.cmp_w2 + (size_t)(l * 2 + kv) * 64 * 64; ld = 64; K = 64; dst = (h16*)(p.ws + OFF_W2T) + (size_t)(l * 2 + kv) * 64 * 64; }
      ntk = K / 64;
      const int n0 = (r / ntk) * 64, k0 = (r % ntk) * 64;
#pragma unroll 4
      for (int i = 0; i < 16; ++i) {
        const int kk = i * 4 + (lane >> 4), nn = (lane & 15) * 4, n = n0 + nn;
        float4 v = make_float4(0.f, 0.f, 0.f, 0.f);
        if (kind == 0) { if (n < DIN) v = ntld4(src0 + (size_t)(k0 + kk) * ld + n); }
        else if (kind == 1) v = ntld4(src0 + (size_t)(k0 + kk) * ld + n);
        else { const int G = n >> 5, vv = n & 31, f = 16 * G + 4 * (vv >> 3), which = (vv >> 2) & 1; v = ntld4((which ? src1 : src0) + (size_t)(k0 + kk) * ld + f); }
        h16* tp = tile + kk * 66 + nn;
        tp[0] = (h16)v.x; tp[1] = (h16)v.y; tp[2] = (h16)v.z; tp[3] = (h16)v.w;
      }
      asm volatile("s_waitcnt lgkmcnt(0)" ::: "memory");
      __builtin_amdgcn_wave_barrier();
#pragma unroll 2
      for (int i = 0; i < 8; ++i) {
        const int nn = i * 8 + (lane >> 3), k8 = (lane & 7) * 8; half8 o;
#pragma unroll
        for (int j = 0; j < 8; ++j) o[j] = tile[(k8 + j) * 66 + nn];
        *(half8*)(dst + (size_t)(n0 + nn) * K + k0 + k8) = o;
      }
      asm volatile("s_waitcnt lgkmcnt(0)" ::: "memory");
      __builtin_amdgcn_wave_barrier();
    }
  }
  {
    h16* pe = (h16*)(p.ws + OFF_PE);
    for (int i = blockIdx.x * 512 + tid; i < 4 * 32 * 64; i += gridDim.x * 512) pe[i] = (h16)p.cmp_pe[i];
    float* tab = (float*)(p.ws + OFF_TAB);
    for (int i = blockIdx.x * 512 + tid; i < 8 * 132; i += gridDim.x * 512) {
      const int hh = i / 132, d = i % 132;
      tab[i] = (p.rel_bias[t5_bucket(d > 128 ? 128 : d) * 8 + hh] - p.rel_bias[31 * 8 + hh]) * 1.4426950408889634f;
    }
  }
}

DI void ln_phase(const int wid_s, const h16* __restrict__ y, const float* __restrict__ g, const float* __restrict__ b, h16* __restrict__ o16, float* __restrict__ o32) {
  const int tid_ = opaque_tid(wid_s); const int wave = tid_ >> 6, lane = tid_ & 63;
  float gg[16], bb[16];
#pragma unroll
  for (int c = 0; c < 2; ++c)
#pragma unroll
    for (int j = 0; j < 8; ++j) { gg[c * 8 + j] = g[c * 512 + lane * 8 + j]; bb[c * 8 + j] = b[c * 512 + lane * 8 + j]; }
  for (int row0 = (blockIdx.x * 8 + wave) * 2; row0 < MTOK; row0 += gridDim.x * 16) {
    half8 a0[2], a1[2];
#pragma unroll
    for (int rr = 0; rr < 2; ++rr) { const h16* yr = y + (size_t)(row0 + rr) * 1024; a0[rr] = __builtin_nontemporal_load((const half8*)(yr + lane * 8)); a1[rr] = __builtin_nontemporal_load((const half8*)(yr + 512 + lane * 8)); }
#pragma unroll
    for (int rr = 0; rr < 2; ++rr) {
      const int row = row0 + rr;
      float v[16];
#pragma unroll
      for (int j = 0; j < 8; ++j) { v[j] = (float)a0[rr][j]; v[8 + j] = (float)a1[rr][j]; }
      float s = 0.f;
#pragma unroll
      for (int j = 0; j < 16; ++j) s += v[j];
#pragma unroll
      for (int o = 32; o >= 1; o >>= 1) s += lane_get(s, lane ^ o);
      const float mu = s * (1.f / 1024.f);
      float q = 0.f;
#pragma unroll
      for (int j = 0; j < 16; ++j) { const float d = v[j] - mu; q += d * d; }
#pragma unroll
      for (int o = 32; o >= 1; o >>= 1) q += lane_get(q, lane ^ o);
      const float rs = rsqrtf(q * (1.f / 1024.f) + 1e-5f);
      float r[16];
#pragma unroll
      for (int j = 0; j < 16; ++j) r[j] = (v[j] - mu) * rs * gg[j] + bb[j];
      half8 o0, o1;
#pragma unroll
      for (int j = 0; j < 8; ++j) { o0[j] = (h16)r[j]; o1[j] = (h16)r[8 + j]; }
      if (o16) {
        *(half8*)(o16 + (size_t)row * 1024 + lane * 8) = o0;
        *(half8*)(o16 + (size_t)row * 1024 + 512 + lane * 8) = o1;
      }
      if (o32) {
        float* orow = o32 + (size_t)row * 1024;
        *(float4*)(orow + lane * 8) = make_float4(r[0], r[1], r[2], r[3]);
        *(float4*)(orow + lane * 8 + 4) = make_float4(r[4], r[5], r[6], r[7]);
        *(float4*)(orow + 512 + lane * 8) = make_float4(r[8], r[9], r[10], r[11]);
        *(float4*)(orow + 512 + lane * 8 + 4) = make_float4(r[12], r[13], r[14], r[15]);
      }
    }
  }
}

DI float gelu_tanh(float x) {
  const float u = 0.7978845608028654f * (x + 0.044715f * x * x * x);
  const float t = __expf(2.f * u);
  const float th = 1.f - 2.f / (t + 1.f);
  return 0.5f * x * (1.f + th);
}

DI void mixers_phase(const Params& p, const int l, const int wid_s) {
  const int tid = opaque_tid(wid_s), wave = tid >> 6, lane = tid & 63, fr = lane & 15, fq = lane >> 4;
  const h16* h = (const h16*)(p.ws + OFF_H);
  h16* mix = (h16*)(p.ws + OFF_MIX);
  h16* kc = (h16*)(p.ws + OFF_KC);
  h16* vcT = (h16*)(p.ws + OFF_VCT);
  for (int i = blockIdx.x * 512 + tid; i < 64 * 64; i += gridDim.x * 512) {
    const int bg = i >> 6, d = i & 63;
    kc[((size_t)bg * 128 + 127) * 64 + d] = (h16)0.f;
    vcT[(((size_t)bg * 4 + 3) * 64 + d) * 32 + 31] = (h16)0.f;
  }
  {
    const int tsk = (wave & 3) * gridDim.x + blockIdx.x, half = wave >> 2;
    const bool act = tsk < 1016;
    const int kv = act ? tsk / 508 : 0, rt = act ? tsk % 508 : 0;
    const int r = rt * 16 + fr, bg = r / 127, n = r % 127, b = bg >> 1, g = bg & 1;
    f32x4 a1[4];
#pragma unroll
    for (int e = 0; e < 4; ++e) a1[e] = (f32x4){0.f, 0.f, 0.f, 0.f};
    if (act) {
      const h16* zb = h + ((size_t)b * SEQ + n * 16) * LDH + (kv ? C_VC : C_KC) + g * 64;
      const h16* pe = (const h16*)(p.ws + OFF_PE) + (size_t)(l * 2 + kv) * 32 * 64;
      const h16* w1t = (const h16*)(p.ws + OFF_W1T) + (size_t)(l * 2 + kv) * 64 * 2048;
#pragma unroll 4
      for (int s = half * 32; s < half * 32 + 32; ++s) {
        const int i = s >> 1, d = (s & 1) * 32 + fq * 8;
        half8 zf = *(const half8*)(zb + (size_t)i * LDH + d);
        const half8 pf = *(const half8*)(pe + i * 64 + d);
        zf = zf + pf;
#pragma unroll
        for (int e = 0; e < 4; ++e) {
          const half8 wf = *(const half8*)(w1t + (size_t)(e * 16 + fr) * 2048 + s * 32 + fq * 8);
          a1[e] = MFMA16(wf, zf, a1[e]);
        }
      }
    }
    float* red = (float*)smem + (wave & 3) * (16 * 64) + lane;
    if (act && half == 1) {
#pragma unroll
      for (int e = 0; e < 4; ++e)
#pragma unroll
        for (int j = 0; j < 4; ++j) red[(e * 4 + j) * 64] = a1[e][j];
    }
    __syncthreads();
    if (act && half == 0) {
#pragma unroll
      for (int e = 0; e < 4; ++e)
#pragma unroll
        for (int j = 0; j < 4; ++j) a1[e][j] += red[(e * 4 + j) * 64];
      const h16* w2t = (const h16*)(p.ws + OFF_W2T) + (size_t)(l * 2 + kv) * 64 * 64;
      f32x4 a2[4];
#pragma unroll
      for (int d = 0; d < 4; ++d) a2[d] = (f32x4){0.f, 0.f, 0.f, 0.f};
#pragma unroll
      for (int s2 = 0; s2 < 2; ++s2) {
        half8 gf;
#pragma unroll
        for (int j = 0; j < 4; ++j) { gf[j] = (h16)gelu_tanh(a1[2 * s2][j]); gf[4 + j] = (h16)gelu_tanh(a1[2 * s2 + 1][j]); }
#pragma unroll
        for (int dt = 0; dt < 4; ++dt) {
          const half4 w0 = *(const half4*)(w2t + (dt * 16 + fr) * 64 + 32 * s2 + fq * 4);
          const half4 w1 = *(const half4*)(w2t + (dt * 16 + fr) * 64 + 32 * s2 + 16 + fq * 4);
          const half8 wf = __builtin_shufflevector(w0, w1, 0, 1, 2, 3, 4, 5, 6, 7);
          a2[dt] = MFMA16(wf, gf, a2[dt]);
        }
      }
      if (kv == 0) {
#pragma unroll
        for (int dt = 0; dt < 4; ++dt) {
          half4 o = {(h16)a2[dt][0], (h16)a2[dt][1], (h16)a2[dt][2], (h16)a2[dt][3]};
          *(half4*)(kc + ((size_t)bg * 128 + n) * 64 + dt * 16 + fq * 4) = o;
        }
      } else {
#pragma unroll
        for (int dt = 0; dt < 4; ++dt)
#pragma unroll
          for (int j = 0; j < 4; ++j) { const int ko = n & 31, pos = ko < 16 ? ((ko >> 2) * 8 + (ko & 3)) : (((ko - 16) >> 2) * 8 + 4 + (ko & 3));
            vcT[(((size_t)bg * 4 + (n >> 5)) * 64 + dt * 16 + fq * 4 + j) * 32 + pos] = (h16)a2[dt][j]; }
      }
    }
    __syncthreads();
  }
  for (int rp_12 = 0; rp_12 < (((p.probe_mask >> 12) & 1) ? 2 : 1); ++rp_12) {
  {
    const float* cw = p.conv_w + (size_t)l * 3 * 256;
    const int c8 = (tid & 31) * 8;
    float w0[8], w1[8], w2[8];
#pragma unroll
    for (int j = 0; j < 8; ++j) { w0[j] = cw[c8 + j]; w1[j] = cw[256 + c8 + j]; w2[j] = cw[512 + c8 + j]; }
    for (int quad = blockIdx.x * 16 + (tid >> 5); quad < MTOK / 4; quad += gridDim.x * 16) {
      const int row0 = quad * 4, t0 = row0 & (SEQ - 1);
      const h16* hr = h + (size_t)row0 * LDH;
      half8 cg[6], xg[6], bgv[4];
#pragma unroll
      for (int i = 0; i < 6; ++i) {
        if (i >= 2 || t0 > 0) { cg[i] = *(const half8*)(hr + (i - 2) * LDH + C_CG + c8); xg[i] = *(const half8*)(hr + (i - 2) * LDH + C_XC + c8); }
        else {
#pragma unroll
          for (int j = 0; j < 8; ++j) { cg[i][j] = (h16)0.f; xg[i][j] = (h16)0.f; }
        }
      }
#pragma unroll
      for (int i = 0; i < 4; ++i) bgv[i] = *(const half8*)(hr + i * LDH + C_BG + c8);
      float u[6][8];
#pragma unroll
      for (int i = 0; i < 6; ++i)
#pragma unroll
        for (int j = 0; j < 8; ++j) u[i][j] = (float)cg[i][j] * (float)xg[i][j];
#pragma unroll
      for (int i = 0; i < 4; ++i) {
        half8 o;
#pragma unroll
        for (int j = 0; j < 8; ++j) o[j] = (h16)((float)bgv[i][j] * (w0[j] * u[i][j] + w1[j] * u[i + 1][j] + w2[j] * u[i + 2][j]));
        *(half8*)(mix + (size_t)(row0 + i) * 1024 + c8) = o;
      }
    }
  }
  }
  for (int rp_13 = 0; rp_13 < (((p.probe_mask >> 13) & 1) ? 2 : 1); ++rp_13) {
    constexpr int UST = 264, WST = 72;
    h16* ul = (h16*)smem;
    h16* wt = (h16*)smem + 143 * UST;
    const float* pw = p.pool_w + (size_t)l * 4 * 64 * 64;
    const float* psc = p.pool_scale + (size_t)l * 256;
    __syncthreads();
    for (int i = tid; i < 4 * 64 * 64; i += 512) { const int gc = i >> 6, dd = i & 63, gi = gc >> 6, c = gc & 63; wt[(gi * 64 + dd) * WST + c] = (h16)pw[i]; }
    for (int tile = blockIdx.x; tile < MTOK / 128; tile += gridDim.x) {
      const int row0 = tile * 128, t0 = row0 & (SEQ - 1);
      for (int e = tid; e < 143 * 32; e += 512) {
        const int rr = e >> 5, ch = (e & 31) * 8, t = t0 - 15 + rr;
        half8 v;
#pragma unroll
        for (int j = 0; j < 8; ++j) v[j] = (h16)0.f;
        if (t >= 0) v = *(const half8*)(h + (size_t)(row0 - 15 + rr) * LDH + C_XP + ch);
        *(half8*)(ul + rr * UST + ch) = v;
      }
      __syncthreads();
      {
        const int tok = wave * 16 + fr, t = t0 + tok;
        const h16* ub = ul + (15 + tok) * UST;
#pragma unroll
        for (int gi = 0; gi < 4; ++gi) {
          const int w = 2 << gi;
          const float rc = 1.f / (float)((t + 1) < w ? (t + 1) : w);
          half8 bd[2];
#pragma unroll
          for (int ks = 0; ks < 2; ++ks) {
            const h16* up = ub + gi * 64 + ks * 32 + fq * 8;
            const half8 u0 = *(const half8*)up;
            float s[8];
#pragma unroll
            for (int j = 0; j < 8; ++j) s[j] = (float)u0[j];
#pragma unroll
            for (int i = 1; i < w; ++i) { const half8 ui = *(const half8*)(up - i * UST);
#pragma unroll
              for (int j = 0; j < 8; ++j) s[j] += (float)ui[j]; }
#pragma unroll
            for (int j = 0; j < 8; ++j) bd[ks][j] = (h16)(s[j] * rc - (float)u0[j]);
          }
          f32x4 o[4];
#pragma unroll
          for (int dt = 0; dt < 4; ++dt) {
            o[dt] = (f32x4){0.f, 0.f, 0.f, 0.f};
#pragma unroll
            for (int ks = 0; ks < 2; ++ks) {
              const half8 wf = *(const half8*)(wt + (gi * 64 + dt * 16 + fr) * WST + ks * 32 + fq * 8);
              o[dt] = MFMA16(wf, bd[ks], o[dt]);
            }
          }
#pragma unroll
          for (int dt = 0; dt < 4; ++dt) {
            const f32x4 sc = *(const f32x4*)(psc + gi * 64 + dt * 16 + fq * 4);
            half4 ov = {(h16)(o[dt][0] * sc[0]), (h16)(o[dt][1] * sc[1]), (h16)(o[dt][2] * sc[2]), (h16)(o[dt][3] * sc[3])};
            *(half4*)(mix + (size_t)(row0 + tok) * 1024 + 768 + gi * 64 + dt * 16 + fq * 4) = ov;
          }
        }
      }
      __syncthreads();
    }
  }
  for (int rp_14 = 0; rp_14 < (((p.probe_mask >> 14) & 1) ? 2 : 1); ++rp_14) {
  {
    unsigned* kmx = (unsigned*)(p.ws + OFF_KMAX) + l * 128;
    for (int task = blockIdx.x * 8 + wave; task < 8192; task += gridDim.x * 8) {
      const int ts = task >> 12, rem = task & 4095, bg = rem >> 6, st = rem & 63, b = bg >> 1, g = bg & 1;
      const h16* src = h + ((size_t)b * SEQ + st * 32) * LDH + (ts ? C_KW : C_KS) + g * 64;
      float n2 = 0.f;
#pragma unroll
      for (int kt = 0; kt < 2; ++kt) {
        float a = 0.f;
#pragma unroll
        for (int ks = 0; ks < 2; ++ks) {
          const half8 v = *(const half8*)(src + (size_t)(kt * 16 + fr) * LDH + ks * 32 + fq * 8);
#pragma unroll
          for (int j = 0; j < 8; ++j) a += (float)v[j] * (float)v[j];
        }
        a += lane_get(a, lane ^ 16); a += lane_get(a, lane ^ 32);
        n2 = fmaxf(n2, a);
      }
#pragma unroll
      for (int o = 1; o <= 8; o <<= 1) n2 = fmaxf(n2, lane_get(n2, lane ^ o));
      if (lane == 0) atomicMax(kmx + ts * 64 + bg, __float_as_uint(n2));
    }
  }
  {
    h16* tl = (h16*)smem + wave * (64 * 72);
    for (int task = blockIdx.x * 8 + wave; task < 4096; task += gridDim.x * 8) {
      const int ts = task >> 11, rem = task & 2047, bg = rem >> 5, tt = rem & 31, b = bg >> 1, g = bg & 1;
      const h16* src = h + ((size_t)b * SEQ + tt * 64) * LDH + (ts ? C_VW : C_VS) + g * 64;
      h16* dst = (h16*)(p.ws + (ts ? OFF_VWT : OFF_VST)) + ((size_t)bg * 64 + tt * 2) * 64 * 32;
#pragma unroll
      for (int i = 0; i < 8; ++i) { const int tk = i * 8 + (lane >> 3), ch = lane & 7; *(half8*)(tl + tk * 72 + ch * 8) = *(const half8*)(src + (size_t)tk * LDH + ch * 8); }
      asm volatile("s_waitcnt lgkmcnt(0)" ::: "memory");
      __builtin_amdgcn_wave_barrier();
#pragma unroll
      for (int i = 0; i < 8; ++i) {
        const int e = i * 64 + lane, d = e >> 3, tch = e & 7, sp = tch >> 2, f4 = tch & 3; half8 o;
#pragma unroll
        for (int j = 0; j < 4; ++j) { o[j] = tl[(sp * 32 + f4 * 4 + j) * 72 + d]; o[4 + j] = tl[(sp * 32 + 16 + f4 * 4 + j) * 72 + d]; }
        *(half8*)(dst + ((size_t)sp * 64 + d) * 32 + f4 * 8) = o;
      }
      asm volatile("s_waitcnt lgkmcnt(0)" ::: "memory");
      __builtin_amdgcn_wave_barrier();
    }
  }
  }
}

DI float fmax_nc(float a, float b) { return __builtin_amdgcn_fmed3f(a, b, __builtin_inff()); }
DI float red4_max(float v, int lane) {
  const unsigned u = __float_as_uint(v);
  const auto r = __builtin_amdgcn_permlane16_swap(u, u, false, false);
  const float w = fmax_nc(__uint_as_float(r[0]), __uint_as_float(r[1]));
  const unsigned x = __float_as_uint(w);
  const auto s = __builtin_amdgcn_permlane32_swap(x, x, false, false);
  return fmax_nc(__uint_as_float(s[0]), __uint_as_float(s[1]));
}
DI float red4_sum(float v, int lane) { v += lane_get(v, lane ^ 16); v += lane_get(v, lane ^ 32); return v; }

typedef float f32x2 __attribute__((ext_vector_type(2)));
constexpr float M_INIT = -1e20f, MASKV = -1e30f;
DI float max8(const f32x4 a, const f32x4 b) { return fmax_nc(fmax_nc(fmax_nc(a[0], a[1]), fmax_nc(a[2], a[3])), fmax_nc(fmax_nc(b[0], b[1]), fmax_nc(b[2], b[3]))); }
DI half8 pack8(const f32x4 a, const f32x4 b) {
  typedef __fp16 fp16x2 __attribute__((ext_vector_type(2)));
  union { fp16x2 h[4]; half8 v; } u;
  u.h[0] = __builtin_amdgcn_cvt_pkrtz(a[0], a[1]); u.h[1] = __builtin_amdgcn_cvt_pkrtz(a[2], a[3]);
  u.h[2] = __builtin_amdgcn_cvt_pkrtz(b[0], b[1]); u.h[3] = __builtin_amdgcn_cvt_pkrtz(b[2], b[3]);
  return u.v;
}
struct KF { half8 k[2][2]; half8 v[4]; };
DI void load_k(KF& r, const h16* __restrict__ kbase, const h16* __restrict__ vT, const int kb, const unsigned koff, const unsigned voff) {
  const char* ku = (const char*)kbase + (size_t)kb * (LDH * 2);
  const char* vu = (const char*)vT + (size_t)(kb >> 5) * (64 * 32 * 2);
#pragma unroll
  for (int kt = 0; kt < 2; ++kt)
#pragma unroll
    for (int ks = 0; ks < 2; ++ks) r.k[kt][ks] = *(const half8*)(ku + (size_t)kt * (16 * LDH * 2) + ks * 64 + koff);
#pragma unroll
  for (int dt = 0; dt < 4; ++dt) r.v[dt] = *(const half8*)(vu + dt * (16 * 32 * 2) + voff);
}

template <bool SEL, bool GEN>
DI void attn_step(const KF& kv, const int kb, const int t, const int lane, const bool selbit,
                  const LAS float* tabh, const half8 (&q)[2][2], f32x4 (&O)[2][4], const float (&nR)[2], float (&l)[2]) {
  const int fq = lane >> 4;
  f32x4 s[2][2];
#pragma unroll
  for (int hp = 0; hp < 2; ++hp) {
    float nm = nR[hp];
    if (SEL) nm = selbit ? nm : MASKV;
    const f32x4 c0 = {nm, nm, nm, nm};
#pragma unroll
    for (int kt = 0; kt < 2; ++kt) {
      s[hp][kt] = MFMA16(kv.k[kt][0], q[hp][0], c0);
      s[hp][kt] = MFMA16(kv.k[kt][1], q[hp][1], s[hp][kt]);
    }
  }
  if (GEN) {
    const int d0 = t - kb - fq * 4;
#pragma unroll
    for (int kt = 0; kt < 2; ++kt)
#pragma unroll
      for (int j = 0; j < 4; ++j) {
        const int dist = d0 - (kt * 16 + j);
        const bool bad = SEL ? (dist < 0) : ((unsigned)dist >= 512u);
        const int ix = bad ? 130 : (dist > 128 ? 128 : dist);
#pragma unroll
        for (int hp = 0; hp < 2; ++hp) s[hp][kt][j] += tabh[hp * 132 + ix];
      }
  }
  half8 pf[2];
#pragma unroll
  for (int hp = 0; hp < 2; ++hp) {
    f32x4 p0, p1;
#pragma unroll
    for (int j = 0; j < 4; ++j) { p0[j] = __builtin_amdgcn_exp2f(s[hp][0][j]); p1[j] = __builtin_amdgcn_exp2f(s[hp][1][j]); }
    l[hp] += ((p0[0] + p0[1]) + (p0[2] + p0[3])) + ((p1[0] + p1[1]) + (p1[2] + p1[3]));
    pf[hp] = pack8(p0, p1);
  }
#pragma unroll
  for (int dt = 0; dt < 4; ++dt)
#pragma unroll
    for (int hp = 0; hp < 2; ++hp) O[hp][dt] = MFMA16(kv.v[dt], pf[hp], O[hp][dt]);
}

DI void attn_phase(const Params& p, const int layer, const int wid_s) {
  const int tid = opaque_tid(wid_s), wave = __builtin_amdgcn_readfirstlane(tid >> 6), lane = tid & 63, fr = lane & 15, fq = lane >> 4;
  const unsigned koff = (unsigned)(fr * LDH + fq * 8) * 2u, voff = (unsigned)(fr * 32 + fq * 8) * 2u;
  LAS float* tab = (LAS float*)smem;
  LAS float* impb = (LAS float*)((LAS unsigned char*)smem + 4224) + wave * 576 + fr * 36;
  LAS float* impx = (LAS float*)((LAS unsigned char*)smem + 4224 + 18432) + lane;
  LAS float* fin = (LAS float*)((LAS unsigned char*)smem + 4224 + 18432 + 16384) + wave * 2048 + lane;
  {
    const float* tg = (const float*)(p.ws + OFF_TAB);
    for (int i = tid; i < 8 * 132; i += 512) tab[i] = tg[i];
  }
  __syncthreads();
  if (tid < 8) { float bm = 0.f; for (int i = 0; i <= 128; ++i) bm = fmaxf(bm, tab[tid * 132 + i]); tab[tid * 132 + 129] = bm; tab[tid * 132 + 130] = MASKV; }
  __syncthreads();
  const h16* h = (const h16*)(p.ws + OFF_H);
  h16* mix = (h16*)(p.ws + OFF_MIX);
  const int nunits = BATCH * 2 * 32;
  const int hpair = wave >> 2;
  for (int it = 0; it * (int)gridDim.x < nunits; ++it) {
    const int vb = vbid();
    const int uid = it * (int)gridDim.x + vb;
    const bool active = uid < nunits;
    int bg, q0;
    if (gridDim.x == 256) { bg = it * 8 + (vb & 7); q0 = vb >> 3; } else { bg = uid >> 5; q0 = uid & 31; }
    if (!active) { bg = 0; q0 = 0; }
    const int qblk = (it & 1) ? 31 - q0 : q0;
    const int b = bg >> 1, g = bg & 1;
    const int t0 = qblk * 64 + (wave & 3) * 16, t = t0 + fr, cur = qblk;
    const int hh0 = g * 4 + hpair * 2;
    const h16* hb = h + (size_t)b * SEQ * LDH;
    const LAS float* tabh = tab + hh0 * 132;
    half8 q[2][2];
#pragma unroll
    for (int hp = 0; hp < 2; ++hp)
#pragma unroll
      for (int ks = 0; ks < 2; ++ks) {
        half8 qq = *(const half8*)(hb + (size_t)t * LDH + C_Q + (hh0 + hp) * 64 + ks * 32 + fq * 8);
        q[hp][ks] = qq * (h16)0.18033688011112042f;
      }
    float gate[2][3];
#pragma unroll
    for (int hp = 0; hp < 2; ++hp)
#pragma unroll
      for (int br = 0; br < 3; ++br) {
        const float gl = (float)hb[(size_t)t * LDH + C_GL + (hh0 + hp) * 3 + br];
        gate[hp][br] = 1.f / (1.f + __expf(-gl));
      }
    unsigned selmask;
    {
      int fql = fq; asm volatile("" : "+v"(fql));
      const int dbase = t - 31 - fql * 64;
      const h16* kcb = (const h16*)(p.ws + OFF_KC) + (size_t)bg * 128 * 64;
      const h16* vcb = (const h16*)(p.ws + OFF_VCT) + (size_t)bg * 64 * 128;
      half8 kc0[8], kc1[8];
#pragma unroll
      for (int nt = 0; nt < 8; ++nt) {
        if (nt * 256 > t0 - 16) { kc0[nt] = (half8){0, 0, 0, 0, 0, 0, 0, 0}; kc1[nt] = kc0[nt]; }
        else { kc0[nt] = *(const half8*)(kcb + (nt * 16 + fr) * 64 + fq * 8); kc1[nt] = *(const half8*)(kcb + (nt * 16 + fr) * 64 + 32 + fq * 8); }
      }
#pragma unroll
      for (int hp = 0; hp < 2; ++hp) {
        half8 qc[2];
#pragma unroll
        for (int ks = 0; ks < 2; ++ks) qc[ks] = hp ? q[1][ks] : q[0][ks];
        const float gate_c = hp ? gate[1][0] : gate[0][0];
        f32x4 s[8];
        float mx = M_INIT;
#pragma unroll
        for (int nt = 0; nt < 8; ++nt) {
          const bool tinv = nt * 256 > t0 - 16, tfar = nt * 256 + 399 <= t0;
          if (tinv) { s[nt] = (f32x4){MASKV, MASKV, MASKV, MASKV}; }
          else {
            s[nt] = MFMA16(kc0[nt], qc[0], ((f32x4){0.f, 0.f, 0.f, 0.f}));
            s[nt] = MFMA16(kc1[nt], qc[1], s[nt]);
            if (!tfar) {
#pragma unroll
              for (int j = 0; j < 4; ++j) {
                const int dist = dbase - (nt * 256 + j * 16);
                const int ix = dist < 0 ? 0 : (dist > 128 ? 128 : dist);
                const float bv = tabh[hp * 132 + ix];
                const float sv = s[nt][j] + bv;
                s[nt][j] = dist >= 0 ? sv : MASKV;
              }
            }
            mx = fmax_nc(mx, fmax_nc(fmax_nc(s[nt][0], s[nt][1]), fmax_nc(s[nt][2], s[nt][3])));
          }
        }
        mx = red4_max(mx, lane);
        float ps = 0.f;
#pragma unroll
        for (int nt = 0; nt < 8; ++nt) {
          const bool tinv = nt * 256 > t0 - 16;
          if (tinv) { s[nt] = (f32x4){0.f, 0.f, 0.f, 0.f}; }
          else {
#pragma unroll
            for (int j = 0; j < 4; ++j) { const float pv = __builtin_amdgcn_exp2f(s[nt][j] - mx); ps += pv; s[nt][j] = pv; }
          }
        }
        ps = red4_sum(ps, lane);
        const float inv = ps > 0.f ? 1.f / ps : 0.f;
#pragma unroll
        for (int nt = 0; nt < 8; ++nt) s[nt] = s[nt] * inv;
        if (cur >= 8)
#pragma unroll
        for (int nt = 0; nt < 8; ++nt) {
          const float x1 = lane_get(s[nt][3], (lane - 16) & 63);
          const float x2 = nt > 0 ? lane_get(s[nt > 0 ? nt - 1 : 0][3], (lane - 16) & 63) : 0.f;
          const float left = fq > 0 ? x1 : x2;
          const float im = left + 2.f * (s[nt][0] + s[nt][1] + s[nt][2]) + s[nt][3];
          LAS float* ip = impx + (wave * 8 + nt) * 64;
          if (hp == 0) *ip = im; else *ip += im;
        }
        f32x4 o[4];
#pragma unroll
        for (int dt = 0; dt < 4; ++dt) o[dt] = (f32x4){0.f, 0.f, 0.f, 0.f};
#pragma unroll
        for (int st = 0; st < 4; ++st) {
          if (2 * st * 256 > t0 - 16) continue;
          const half8 pf = {(h16)s[2 * st][0], (h16)s[2 * st][1], (h16)s[2 * st][2], (h16)s[2 * st][3],
                            (h16)s[2 * st + 1][0], (h16)s[2 * st + 1][1], (h16)s[2 * st + 1][2], (h16)s[2 * st + 1][3]};
#pragma unroll
          for (int dt = 0; dt < 4; ++dt) {
            const half8 vf = *(const half8*)(vcb + ((st * 64) + dt * 16 + fr) * 32 + fq * 8);
            o[dt] = MFMA16(vf, pf, o[dt]);
          }
        }
#pragma unroll
        for (int dt = 0; dt < 4; ++dt)
#pragma unroll
          for (int j = 0; j < 4; ++j) fin[(hp * 16 + dt * 4 + j) * 64] = o[dt][j] * gate_c;
      }
      unsigned mk = (2u << cur) - 1u;
      if (cur >= 8) {
      float impv[8];
      __syncthreads();
#pragma unroll
      for (int nt = 0; nt < 8; ++nt) {
        const float mine = impx[(wave * 8 + nt) * 64], other = impx[((wave ^ 4) * 8 + nt) * 64];
        const float im = hpair == 0 ? mine + other : other + mine;
        const int jb = nt * 4 + fql;
        const bool forced = (jb == 0) || (jb == cur) || (jb == cur - 1);
        impv[nt] = jb <= cur ? im + (forced ? 1e6f : 0.f) : NEGF;
        impb[jb] = impv[nt];
      }
      __syncthreads();
      int cnt[8];
#pragma unroll
      for (int nt = 0; nt < 8; ++nt) cnt[nt] = 0;
#pragma unroll
      for (int i = 0; i < 8; ++i) {
        const f32x4 r4 = *(const LAS f32x4*)(impb + 4 * i);
        const float rv[4] = {r4[0], r4[1], r4[2], r4[3]};
#pragma unroll
        for (int nt = 0; nt < 8; ++nt) {
          const float a = impv[nt]; const int ja = nt * 4 + fql;
#pragma unroll
          for (int c = 0; c < 4; ++c) cnt[nt] += (int)(rv[c] > a) | ((int)(rv[c] == a) & (int)((4 * i + c) < ja));
        }
      }
      mk = 0;
#pragma unroll
      for (int nt = 0; nt < 8; ++nt) { const int ja = nt * 4 + fql; if (cnt[nt] < 8 && ja <= cur) mk |= 1u << ja; }
      mk |= (unsigned)lane_get_i((int)mk, lane ^ 16);
      mk |= (unsigned)lane_get_i((int)mk, lane ^ 32);
      }
      selmask = mk;
    }
    if (!active) continue;
    float nRs[2], nRw[2];
    {
      const float* kmx = (const float*)(p.ws + OFF_KMAX) + layer * 128;
      const float k2s = kmx[bg], k2w = kmx[64 + bg];
#pragma unroll
      for (int hp = 0; hp < 2; ++hp) {
        float q2 = 0.f;
#pragma unroll
        for (int ks = 0; ks < 2; ++ks)
#pragma unroll
          for (int j = 0; j < 8; ++j) q2 += (float)q[hp][ks][j] * (float)q[hp][ks][j];
        q2 = red4_sum(q2, lane);
        const float bm = tabh[hp * 132 + 129];
        nRs[hp] = 12.f - (sqrtf(q2 * k2s) * 1.002f + 0.01f + bm);
        nRw[hp] = 12.f - (sqrtf(q2 * k2w) * 1.002f + 0.01f + bm);
      }
    }
    {
      LAS unsigned char* ring = (LAS unsigned char*)smem + 104576;
      int k_src_off, v_src_off;
      { const int r = tid >> 3, cs = tid & 7, c = cs ^ (r & 7); k_src_off = r * LDH + c * 8; }
      { const int i = tid & 255, r = i >> 2, cs = i & 3, c = cs ^ ((r >> 2) & 3); v_src_off = r * 32 + c * 8; }
      const unsigned stage_dst = (unsigned)(wave < 4 ? wave * 1024 : 4096 + (wave - 4) * 1024);
      unsigned kread[2][2], vread[4];
#pragma unroll
      for (int kt = 0; kt < 2; ++kt)
#pragma unroll
        for (int ks = 0; ks < 2; ++ks) { const int r = kt * 16 + fr, c = ks * 4 + fq; kread[kt][ks] = (unsigned)(r * 128 + ((c ^ (r & 7)) * 16)); }
#pragma unroll
      for (int dt = 0; dt < 4; ++dt) { const int r = dt * 16 + fr; vread[dt] = (unsigned)(4096 + r * 64 + ((fq ^ ((r >> 2) & 3)) * 16)); }
      const int kb_last = qblk * 64 + 32;
      const int kmax_w = (t0 + 15) & ~31;
#pragma unroll 1
      for (int br = 1; br <= 2; ++br) {
        const h16* kbase = hb + (br == 1 ? C_KS : C_KW) + g * 64;
        const h16* vT = (const h16*)(p.ws + (br == 1 ? OFF_VST : OFF_VWT)) + (size_t)bg * 64 * SEQ;
        int kb0 = 0, lo_w = 0;
        if (br == 2) { kb0 = qblk * 64 - 512; if (kb0 < 0) kb0 = 0; lo_w = t0 - 511; if (lo_w < 0) lo_w = 0; lo_w &= ~31; }
        const int nsteps = (kb_last - kb0) / 32 + 1;
        f32x4 O[2][4]; float l[2];
#pragma unroll
        for (int hp = 0; hp < 2; ++hp) { l[hp] = 0.f;
#pragma unroll
          for (int dt = 0; dt < 4; ++dt) O[hp][dt] = (f32x4){0.f, 0.f, 0.f, 0.f}; }
#define RING_ISSUE(SI) do { int kbi = kb0 + (SI) * 32; if (kbi > kb_last) kbi = kb_last; const int slot = (SI) % 3; \
          const h16* srcp = wave < 4 ? kbase + (size_t)kbi * LDH + k_src_off : vT + (size_t)(kbi >> 5) * 2048 + v_src_off; \
          __builtin_amdgcn_global_load_lds((const unsigned*)srcp, (LAS unsigned*)(ring + slot * 8192 + stage_dst), 16, 0, 0); } while (0)
        asm volatile("s_waitcnt vmcnt(0)" ::: "memory");
        __syncthreads();
        RING_ISSUE(0); RING_ISSUE(1);
#pragma unroll 1
        for (int si = 0; si < nsteps; ++si) {
          asm volatile("s_waitcnt vmcnt(1) lgkmcnt(0)" ::: "memory");
          __builtin_amdgcn_s_barrier();
          asm volatile("" ::: "memory");
          RING_ISSUE(si + 2);
          const int kb = kb0 + si * 32;
          if (kb > kmax_w || kb < lo_w) continue;
          if (br == 1 && kb + 31 + 128 <= t0 && __ballot((selmask >> (kb >> 6)) & 1u) == 0ull) continue;
          LAS unsigned char* slotp = ring + (si % 3) * 8192;
          KF kv;
#pragma unroll
          for (int kt = 0; kt < 2; ++kt)
#pragma unroll
            for (int ks = 0; ks < 2; ++ks) kv.k[kt][ks] = *(const LAS half8*)(slotp + kread[kt][ks]);
#pragma unroll
          for (int dt = 0; dt < 4; ++dt) kv.v[dt] = *(const LAS half8*)(slotp + vread[dt]);
          if (br == 1) {
            const bool bit = (selmask >> (kb >> 6)) & 1u;
            if (kb + 31 + 128 <= t0) attn_step<true, false>(kv, kb, t, lane, bit, tabh, q, O, nRs, l);
            else attn_step<true, true>(kv, kb, t, lane, bit, tabh, q, O, nRs, l);
          } else {
            const bool gen = (kb + 31 + 128 > t0) || (kb + 512 <= t0 + 15);
            if (!gen) attn_step<false, false>(kv, kb, t, lane, true, tabh, q, O, nRw, l);
            else attn_step<false, true>(kv, kb, t, lane, true, tabh, q, O, nRw, l);
          }
        }
#undef RING_ISSUE
        if (br == 1) {
#pragma unroll
          for (int hp = 0; hp < 2; ++hp) {
            const float lt = red4_sum(l[hp], lane);
            const float sc = lt > 0.f ? gate[hp][1] / lt : 0.f;
#pragma unroll
            for (int dt = 0; dt < 4; ++dt)
#pragma unroll
              for (int j = 0; j < 4; ++j) fin[(hp * 16 + dt * 4 + j) * 64] += O[hp][dt][j] * sc;
          }
        } else {
          int t_late = t; asm volatile("" : "+v"(t_late));
#pragma unroll
          for (int hp = 0; hp < 2; ++hp) {
            const float lt = red4_sum(l[hp], lane);
            const float sc = lt > 0.f ? gate[hp][2] / lt : 0.f;
#pragma unroll
            for (int dt = 0; dt < 4; ++dt) {
              half4 o;
#pragma unroll
              for (int j = 0; j < 4; ++j) o[j] = (h16)(fin[(hp * 16 + dt * 4 + j) * 64] + O[hp][dt][j] * sc);
              *(half4*)(mix + ((size_t)b * SEQ + t_late) * 1024 + 256 + (hh0 + hp) * 64 + dt * 16 + fq * 4) = o;
            }
          }
        }
      }
      asm volatile("s_waitcnt vmcnt(0)" ::: "memory");
    }
  }
}

#define XB_TMO      128
#define XB_XCNT(j)  (256  + 64 * (j))
#define XB_XSUB(j)  (1280 + 64 * (j))
#define XB_XGEN(j)  (2304 + 64 * (j))
#define XB_TOP      3328
#define XB_TOPGEN   3392
#define XCD_BAR_WORDS 3456
#define XB_SPIN_CAP (1u << 22)
DI unsigned xb_ld(unsigned* p) { return __hip_atomic_load(p, __ATOMIC_RELAXED, __HIP_MEMORY_SCOPE_AGENT); }
DI unsigned xb_add(unsigned* p, unsigned v) { return __hip_atomic_fetch_add(p, v, __ATOMIC_RELAXED, __HIP_MEMORY_SCOPE_AGENT); }
DI unsigned xb_xcc_id() { return (unsigned)__builtin_amdgcn_s_getreg((3 << 11) | 20) & 0xFu; }
#define XB_SPIN(cond, bar) do { unsigned _sp = 0; while (cond) { __builtin_amdgcn_s_sleep(1); \
    if ((++_sp & 255u) == 0u) { if (xb_ld(&(bar)[XB_TMO])) break; if (_sp > XB_SPIN_CAP) { atomicAdd(&(bar)[XB_TMO], 1u); break; } } } } while (0)
struct XcdBarrier { unsigned* bar; unsigned x; volatile LAS unsigned* st; };
DI XcdBarrier xcd_barrier_post(unsigned* bar, volatile LAS unsigned* st, const bool leader) {
  XcdBarrier b; b.bar = bar; b.x = xb_xcc_id(); b.st = st;
  if (leader) { const unsigned rank = xb_add(&bar[XB_XCNT(b.x)], 1u); st[2] = rank; }
  return b;
}
DI void xcd_barrier_complete(unsigned* bar, unsigned x, unsigned& nloc, unsigned& nx) {
  const unsigned G = gridDim.x * gridDim.y * gridDim.z;
  unsigned sum, cnt, mine, sp = 0u;
  for (;;) {
    sum = 0u; cnt = 0u; mine = 0u;
#pragma unroll
    for (unsigned j = 0; j < 16; ++j) { const unsigned c = xb_ld(&bar[XB_XCNT(j)]); sum += c; cnt += (c > 0u) ? 1u : 0u; mine = (j == x) ? c : mine; }
    if (sum == G) break;
    __builtin_amdgcn_s_sleep(1);
    if ((++sp & 255u) == 0u) { if (xb_ld(&bar[XB_TMO])) break; if (sp > XB_SPIN_CAP) { atomicAdd(&bar[XB_TMO], 1u); break; } }
  }
  nloc = mine > 0u ? mine : 1u; nx = cnt > 0u ? cnt : 1u;
}
DI void xcd_barrier(const XcdBarrier& b, const int wid_s) {
  asm volatile("s_waitcnt vmcnt(0)" ::: "memory");
  __syncthreads();
  int w0 = wid_s; asm volatile("" : "+s"(w0));
  if (w0 == 0 && lane_id_hw() == 0) {
    unsigned* bar = b.bar;
    __builtin_amdgcn_s_waitcnt(0);
    unsigned nloc = b.st[0], nx = b.st[1];
    if (nloc == 0u) { xcd_barrier_complete(bar, b.x, nloc, nx); b.st[0] = nloc; b.st[1] = nx; }
    const unsigned old = xb_add(&bar[XB_XSUB(b.x)], 1u);
    const unsigned gen = old / nloc;
    if (old + 1u == (gen + 1u) * nloc) {
      __builtin_amdgcn_fence(__ATOMIC_RELEASE, "agent");
      asm volatile("s_waitcnt vmcnt(0)" ::: "memory");
      const unsigned og = xb_add(&bar[XB_TOP], 1u);
      const unsigned tg = og / nx;
      if (og + 1u == (tg + 1u) * nx) xb_add(&bar[XB_TOPGEN], 1u);
      else XB_SPIN(xb_ld(&bar[XB_TOPGEN]) == tg, bar);
      __builtin_amdgcn_fence(__ATOMIC_ACQUIRE, "agent");
      xb_add(&bar[XB_XGEN(b.x)], 1u);
      asm volatile("s_waitcnt vmcnt(0)" ::: "memory");
    } else {
      XB_SPIN(xb_ld(&bar[XB_XGEN(b.x)]) == gen, bar);
      __builtin_amdgcn_fence(__ATOMIC_ACQUIRE, "agent");
      asm volatile("s_waitcnt vmcnt(0)" ::: "memory");
    }
  }
  __syncthreads();
}

__global__ void __launch_bounds__(512) hymba_fwd(const Params p) {
  cg::grid_group grid = cg::this_grid();
  unsigned char* ws0 = p.ws;
  volatile LAS unsigned* st = (volatile LAS unsigned*)((LAS unsigned char*)smem + 131072);
  const int wid_s = __builtin_amdgcn_readfirstlane((int)(threadIdx.x >> 6));
  if (threadIdx.x == 0) { st[0] = 0u; st[1] = 0u; st[2] = 0u; st[3] = blockIdx.x; }
  __syncthreads();
  const XcdBarrier xb = xcd_barrier_post((unsigned*)(ws0 + OFF_BAR), st, threadIdx.x == 0);
  for (int ph = p.phase_lo; ph < p.phase_hi; ++ph) {
    if (ph > p.phase_lo) {
      int ucg = p.use_cg; asm volatile("" : "+s"(ucg));
      if (ucg) grid.sync(); else xcd_barrier(xb, wid_s);
      if (ph == p.phase_lo + 1 && !ucg && gridDim.x == 256) {
        int w1 = wid_s; asm volatile("" : "+s"(w1));
        if (w1 == 0 && lane_id_hw() == 0) {
          unsigned* bar = (unsigned*)(ws0 + OFF_BAR);
          bool ok = true;
          for (unsigned j = 0; j < 16; ++j) { const unsigned c = xb_ld(&bar[XB_XCNT(j)]); ok = ok && (c == (j < 8 ? 32u : 0u)); }
          const unsigned rank = st[2];
          if (ok && rank < 32u && xb.x < 8u) st[3] = rank * 8u + xb.x;
        }
        __syncthreads();
      }
    }
    const int l = ph == 0 ? 0 : (ph - 1) >> 3, s = ph == 0 ? 8 : (ph - 1) & 7;
    Params pl = p;
    { unsigned char* wl = p.ws; asm volatile("" : "+s"(wl)); pl.ws = wl; }
    unsigned char* ws = pl.ws;
    const int reps = ((p.probe_mask >> s) & 1) ? 2 : 1;
    h16* xa = (h16*)(ws + OFF_XA); h16* mix = (h16*)(ws + OFF_MIX); h16* y = (h16*)(ws + OFF_Y); h16* hbuf = (h16*)(ws + OFF_H);
    for (int rep = 0; rep < reps; ++rep) {
    if (s == 8) prologue(pl, wid_s);
    else if (s == 0) { EpiArgs ea{hbuf, nullptr}; gemm_phase<0>(wid_s, xa, (const h16*)(ws + OFF_WIN + l * SZ_WIN), LDH, 1024, ea); }
    else if (s == 1) mixers_phase(pl, l, wid_s);
    else if (s == 2) attn_phase(pl, l, wid_s);
    else if (s == 3) { EpiArgs ea{y, xa}; gemm_phase<1>(wid_s, mix, (const h16*)(ws + OFF_WOUT + l * SZ_WOUT), 1024, 1024, ea); }
    else if (s == 4) ln_phase(wid_s, y, pl.ln1_g + l * 1024, pl.ln1_b + l * 1024, xa, nullptr);
    else if (s == 5) { EpiArgs ea{hbuf, nullptr}; gemm_phase<2>(wid_s, xa, (const h16*)(ws + OFF_WGU + l * SZ_WGU), 5632, 1024, ea); }
    else if (s == 6) { EpiArgs ea{y, xa}; gemm_phase<1>(wid_s, hbuf, (const h16*)(ws + OFF_WDN + l * SZ_WDN), 1024, DFF, ea); }
    else ln_phase(wid_s, y, pl.ln2_g + l * 1024, pl.ln2_b + l * 1024, l == 1 ? (h16*)nullptr : xa, l == 1 ? pl.out : nullptr);
    }
  }
}

#ifndef USE_CG_SYNC
#define USE_CG_SYNC 0
#endif
#ifndef PROBE_MASK
#define PROBE_MASK 0
#endif
#ifndef SINGLE_LAUNCH
#define SINGLE_LAUNCH 1
#endif

extern "C" void kernel_launch(void* const* d_in, const int* in_sizes, int n_in, void* d_out, int out_size, void* d_ws, size_t ws_size, hipStream_t stream) {
  static int grid_blocks = 0;
  if (!grid_blocks) {
    int dev = 0, cus = 0, per_cu = 0;
    hipGetDevice(&dev);
    hipDeviceGetAttribute(&cus, hipDeviceAttributeMultiprocessorCount, dev);
    hipFuncSetAttribute((const void*)hymba_fwd, hipFuncAttributeMaxDynamicSharedMemorySize, LDS_BYTES);
    hipOccupancyMaxActiveBlocksPerMultiprocessor(&per_cu, hymba_fwd, 512, LDS_BYTES);
    if (per_cu < 1) per_cu = 1;
    grid_blocks = cus * per_cu;
    if (ws_size < WS_NEED) fprintf(stderr, "workspace too small: %zu < %zu\n", ws_size, (size_t)WS_NEED);
  }
  Params p{};
  p.x = (const float*)d_in[0]; p.w_in = (const float*)d_in[1]; p.conv_w = (const float*)d_in[2]; p.cmp_pe = (const float*)d_in[3];
  p.cmp_w1 = (const float*)d_in[4]; p.cmp_w2 = (const float*)d_in[5]; p.pool_w = (const float*)d_in[6]; p.pool_scale = (const float*)d_in[7];
  p.w_out = (const float*)d_in[8]; p.ln1_g = (const float*)d_in[9]; p.ln1_b = (const float*)d_in[10]; p.w_gate = (const float*)d_in[11];
  p.w_up = (const float*)d_in[12]; p.w_down = (const float*)d_in[13]; p.ln2_g = (const float*)d_in[14]; p.ln2_b = (const float*)d_in[15];
  p.rel_bias = (const float*)d_in[16];
  p.out = (float*)d_out; p.ws = (unsigned char*)d_ws; p.probe_mask = PROBE_MASK; p.use_cg = USE_CG_SYNC;
#if SINGLE_LAUNCH
  hipMemsetAsync((unsigned char*)d_ws + OFF_BAR, 0, 16384, stream);
  p.phase_lo = 0; p.phase_hi = NPHASE;
  void* args[] = {&p};
  hipError_t e = hipLaunchCooperativeKernel((const void*)hymba_fwd, dim3(grid_blocks), dim3(512), args, LDS_BYTES, stream);
  if (e != hipSuccess) fprintf(stderr, "cooperative launch failed: %s (grid %d)\n", hipGetErrorString(e), grid_blocks);
#else
  for (int ph = 0; ph < NPHASE; ++ph) {
    p.phase_lo = ph; p.phase_hi = ph + 1;
    hipLaunchKernelGGL(hymba_fwd, dim3(grid_blocks), dim3(512), LDS_BYTES, stream, p);
  }
#endif
}
```

```cpp
#include <hip/hip_runtime.h>
#include <hip/hip_cooperative_groups.h>
#include <cstdio>
#include <cstdint>
namespace cg = cooperative_groups;

typedef _Float16 h16;
typedef _Float16 half8 __attribute__((ext_vector_type(8)));
typedef _Float16 half4 __attribute__((ext_vector_type(4)));
typedef float f32x4 __attribute__((ext_vector_type(4)));
#define DI __device__ __forceinline__
__device__ __forceinline__ int lane_id_hw() { int l; asm volatile("v_mbcnt_lo_u32_b32 %0, -1, 0\n\tv_mbcnt_hi_u32_b32 %0, -1, %0" : "=v"(l)); return l; }
__device__ __forceinline__ int opaque_tid(int wid_s) { int t = wid_s * 64 + lane_id_hw(); asm volatile("" : "+v"(t)); return t; }
#define MFMA16(a, b, c) __builtin_amdgcn_mfma_f32_16x16x32_f16((a), (b), (c), 0, 0, 0)

DI float lane_get(float v, int srclane) { return __int_as_float(__builtin_amdgcn_ds_bpermute(srclane << 2, __float_as_int(v))); }
DI int lane_get_i(int v, int srclane) { return __builtin_amdgcn_ds_bpermute(srclane << 2, v); }
constexpr int SEQ = 2048, BATCH = 32, MTOK = BATCH * SEQ, DM = 1024, DIN = 2328, LDH = 2560, DFF = 2816;
constexpr int C_BG = 0, C_CG = 256, C_XC = 512, C_Q = 768, C_KC = 1280, C_VC = 1408, C_KS = 1536, C_VS = 1664, C_KW = 1792, C_VW = 1920, C_GL = 2048, C_XP = 2072;
constexpr float ALPHA_F = 1.41421356237309515f;
constexpr float NEGF = -1e30f;
constexpr int NPHASE = 17;

constexpr size_t SZ_WIN = (size_t)LDH * 1024 * 2, SZ_WOUT = (size_t)1024 * 1024 * 2, SZ_WGU = (size_t)5632 * 1024 * 2, SZ_WDN = (size_t)1024 * DFF * 2;
constexpr size_t OFF_WIN = 0;
constexpr size_t OFF_WOUT = OFF_WIN + 2 * SZ_WIN;
constexpr size_t OFF_WGU = OFF_WOUT + 2 * SZ_WOUT;
constexpr size_t OFF_WDN = OFF_WGU + 2 * SZ_WGU;
constexpr size_t OFF_W1T = OFF_WDN + 2 * SZ_WDN;
constexpr size_t OFF_W2T = OFF_W1T + 4 * 64 * 2048 * 2;
constexpr size_t OFF_PE = OFF_W2T + 4 * 64 * 64 * 2;
constexpr size_t OFF_TAB = OFF_PE + 4 * 32 * 64 * 2;
constexpr size_t OFF_KC = OFF_TAB + 8192;
constexpr size_t OFF_VCT = OFF_KC + 64 * 128 * 64 * 2;
constexpr size_t OFF_VST = OFF_VCT + 64 * 128 * 64 * 2;
constexpr size_t OFF_VWT = OFF_VST + (size_t)64 * 64 * 2048 * 2;
constexpr size_t OFF_XA = OFF_VWT + (size_t)64 * 64 * 2048 * 2;
constexpr size_t OFF_MIX = OFF_XA + (size_t)MTOK * 1024 * 2;
constexpr size_t OFF_Y = OFF_MIX + (size_t)MTOK * 1024 * 2;
constexpr size_t OFF_H = OFF_Y + (size_t)MTOK * 1024 * 2;
constexpr size_t OFF_BAR = OFF_H + (size_t)MTOK * DFF * 2;
constexpr size_t OFF_KMAX = OFF_BAR + 14336;
constexpr size_t WS_NEED = OFF_BAR + 16384;

constexpr int LDS_BYTES = 131072 + 16;

struct Params {
  const float *x, *w_in, *conv_w, *cmp_pe, *cmp_w1, *cmp_w2, *pool_w, *pool_scale, *w_out, *ln1_g, *ln1_b, *w_gate, *w_up, *w_down, *ln2_g, *ln2_b, *rel_bias;
  float* out;
  unsigned char* ws;
  int phase_lo, phase_hi, probe_mask, use_cg;
};

extern __shared__ __attribute__((aligned(16))) unsigned char smem[];
#define LAS_ __attribute__((address_space(3)))
__device__ __forceinline__ int vbid() { return __builtin_amdgcn_readfirstlane((int)((volatile LAS_ unsigned*)((LAS_ unsigned char*)smem + 131072))[3]); }

constexpr int BK = 64, HALF = 128, HT = HALF * BK;
DI int lds_byte(int r, int c) { int st = (r >> 4) * 2 + (c >> 5), rr = r & 15, cc = c & 31, ob = rr * 64 + cc * 2; return st * 1024 + (ob ^ (((ob >> 9) & 1) << 5)); }
DI void stage_rc(int b, int& R, int& C) { int st = b / 1024, sb = b % 1024, swz = sb ^ (((sb >> 9) & 1) << 5); R = (st >> 1) * 16 + swz / 64; C = (st & 1) * 32 + (swz % 64) / 2; }

struct EpiArgs { h16* out; const h16* res; };

#define LAS __attribute__((address_space(3)))
DI int perm32(int rho) { const int n = rho >> 4, i = rho & 15; return 8 * (i >> 2) + 4 * n + (i & 3); }

template <int EPI>
DI void gemm_phase(const int wid_s, const h16* __restrict__ A, const h16* __restrict__ Bt, const int N, const int K, const EpiArgs ea) {
  LAS unsigned char* lds = (LAS unsigned char*)smem;
  const int tid = opaque_tid(wid_s), wid = __builtin_amdgcn_readfirstlane(tid >> 6), lane = tid & 63, wr = wid >> 2, wc = wid & 3, fr = lane & 15, fq = lane >> 4;
  unsigned voffA[2], voffB[2];
#pragma unroll
  for (int i = 0; i < 2; ++i) { int R, C; stage_rc(tid * 16 + i * 8192, R, C); const int Rb = (R & ~31) + perm32(R & 31);
    voffA[i] = (unsigned)(R * K + C) * 2u; voffB[i] = (unsigned)(Rb * K + C) * 2u; }
  const size_t kstep = (size_t)(BK * 2), hstep = (size_t)HALF * K * 2;
  const unsigned ldsw = (unsigned)wid * 1024u;
  const int aoff = lds_byte(wr * 64 + fr, fq * 8), boff = lds_byte(wc * 32 + fr, fq * 8);
  constexpr int HTB = HT * 2;
#define SA(b, h) (((b) * 2 + (h)) * HTB)
#define SB(b, h) ((4 + (b) * 2 + (h)) * HTB)
#define STAGE(bufoff, gbase, voff) do { _Pragma("unroll") for (int _i = 0; _i < 2; ++_i) \
    __builtin_amdgcn_global_load_lds((const unsigned*)((const char*)(gbase) + (voff)[_i]), (LAS unsigned*)(lds + (bufoff) + ldsw + _i * 8192), 16, 0, 0); } while (0)
#define LDA(dst, b, h) do { _Pragma("unroll") for (int m = 0; m < 4; ++m) _Pragma("unroll") for (int k = 0; k < 2; ++k) dst[m][k] = *(const LAS half8*)(lds + SA(b, h) + aoff + m * 2048 + k * 1024); } while (0)
#define LDB(dst, b, h) do { _Pragma("unroll") for (int n = 0; n < 2; ++n) _Pragma("unroll") for (int k = 0; k < 2; ++k) dst[n][k] = *(const LAS half8*)(lds + SB(b, h) + boff + n * 2048 + k * 1024); } while (0)
#define MMA(ai, bj, At_, Bt_) do { __builtin_amdgcn_s_setprio(1); \
    _Pragma("unroll") for (int m = 0; m < 4; ++m) _Pragma("unroll") for (int n = 0; n < 2; ++n) _Pragma("unroll") for (int k = 0; k < 2; ++k) \
      acc[ai][bj][m][n] = MFMA16(Bt_[n][k], At_[m][k], acc[ai][bj][m][n]); \
    __builtin_amdgcn_s_setprio(0); } while (0)
#define WAIT_V(n) asm volatile("s_waitcnt vmcnt(" #n ")" ::: "memory")
#define WAIT_L(n) asm volatile("s_waitcnt lgkmcnt(" #n ")" ::: "memory")
#define BAR __builtin_amdgcn_s_barrier()
#define SCHED __builtin_amdgcn_sched_barrier(0)
#define TILE_RC(L_, brow_, bcol_) do { int wgid = (L_); \
    { const int q = nwg / 8, r = nwg % 8, xcd = wgid % 8, off = wgid / 8; wgid = (xcd < r ? xcd * (q + 1) : r * (q + 1) + (xcd - r) * q) + off; } \
    const int nig = 4 * nN, gid = wgid / nig, fm = gid * 4, gsz = (nM - fm) < 4 ? (nM - fm) : 4; \
    brow_ = (fm + ((wgid % nig) % gsz)) * 256; bcol_ = ((wgid % nig) / gsz) * 256; } while (0)
  const int nM = MTOK / 256, nN = N / 256, nwg = nM * nN;
  const int nt = K / BK;
  int L = vbid();
  if (L >= nwg) return;
  int brow, bcol;
  TILE_RC(L, brow, bcol);
  const char* cA = (const char*)A + (size_t)brow * K * 2;
  const char* cB = (const char*)Bt + (size_t)bcol * K * 2;
  f32x4 acc[2][2][4][2];
#pragma unroll
  for (int a = 0; a < 2; ++a)
#pragma unroll
    for (int b = 0; b < 2; ++b)
#pragma unroll
      for (int m = 0; m < 4; ++m)
#pragma unroll
        for (int n = 0; n < 2; ++n) acc[a][b][m][n] = (f32x4){0.f, 0.f, 0.f, 0.f};
  half8 At[4][2], B0[2][2], B1[2][2];
  STAGE(SB(0, 0), cB, voffB); STAGE(SB(0, 1), cB + hstep, voffB); STAGE(SA(0, 0), cA, voffA); STAGE(SA(0, 1), cA + hstep, voffA);
  if (wr == 1) BAR;
  WAIT_V(2); BAR;
  STAGE(SB(1, 0), cB + kstep, voffB); STAGE(SA(1, 0), cA + kstep, voffA); STAGE(SB(1, 1), cB + hstep + kstep, voffB);
  WAIT_V(6); BAR;
  for (;;) {
    const int Ln = L + (int)gridDim.x;
    const bool has_next = Ln < nwg;
    int nbrow = brow, nbcol = bcol;
    if (has_next) TILE_RC(Ln, nbrow, nbcol);
    const char* nA = (const char*)A + (size_t)nbrow * K * 2;
    const char* nB = (const char*)Bt + (size_t)nbcol * K * 2;
    for (int t = 0; t < nt; t += 2) {
      const bool last = (t == nt - 2);
      const char* a1 = cA + (size_t)(t + 1) * kstep;
      const char* a2 = last ? nA : cA + (size_t)(t + 2) * kstep; const char* b2 = last ? nB : cB + (size_t)(t + 2) * kstep;
      const char* a3 = a2 + kstep; const char* b3 = b2 + kstep;
      LDB(B0, 0, 0); LDB(B1, 0, 1); SCHED; LDA(At, 0, 0); STAGE(SA(1, 1), a1 + hstep, voffA);
      WAIT_V(8); WAIT_L(0); BAR; MMA(0, 0, At, B0); MMA(0, 1, At, B1); BAR; SCHED;
      LDA(At, 0, 1); STAGE(SB(0, 0), b2, voffB); STAGE(SB(0, 1), b2 + hstep, voffB); STAGE(SA(0, 0), a2, voffA);
      WAIT_V(8); WAIT_L(0); BAR; MMA(1, 0, At, B0); MMA(1, 1, At, B1); BAR; SCHED;
      LDB(B0, 1, 0); LDB(B1, 1, 1); SCHED; LDA(At, 1, 0); STAGE(SA(0, 1), a2 + hstep, voffA);
      WAIT_V(8); WAIT_L(0); BAR; MMA(0, 0, At, B0); MMA(0, 1, At, B1); BAR; SCHED;
      LDA(At, 1, 1); STAGE(SB(1, 0), b3, voffB); STAGE(SB(1, 1), b3 + hstep, voffB); STAGE(SA(1, 0), a3, voffA);
      WAIT_V(8); WAIT_L(0); BAR; MMA(1, 0, At, B0); MMA(1, 1, At, B1); BAR; SCHED;
    }
    if (wr == 0) BAR;
#pragma unroll
    for (int ai = 0; ai < 2; ++ai)
#pragma unroll
      for (int m = 0; m < 4; ++m) {
        const size_t row = (size_t)(brow + ai * HALF + wr * 64 + m * 16 + fr);
#pragma unroll
        for (int bj = 0; bj < 2; ++bj) {
          const int col0 = bcol + bj * HALF + wc * 32 + 8 * fq;
          const f32x4 v0 = acc[ai][bj][m][0], v1 = acc[ai][bj][m][1];
          if (EPI == 0) {
            half8 o = {(h16)v0[0], (h16)v0[1], (h16)v0[2], (h16)v0[3], (h16)v1[0], (h16)v1[1], (h16)v1[2], (h16)v1[3]};
            *(half8*)(ea.out + row * LDH + col0) = o;
          } else if (EPI == 1) {
            const half8 r = *(const half8*)(ea.res + row * 1024 + col0);
            half8 o;
#pragma unroll
            for (int j = 0; j < 4; ++j) { o[j] = (h16)(ALPHA_F * (float)r[j] + v0[j]); o[4 + j] = (h16)(ALPHA_F * (float)r[4 + j] + v1[j]); }
            *(half8*)(ea.out + row * 1024 + col0) = o;
          } else {
            const int f0 = (bcol + bj * HALF + wc * 32) / 2 + 4 * fq;
            half4 o;
#pragma unroll
            for (int j = 0; j < 4; ++j) { const float g = v0[j], u = v1[j]; o[j] = (h16)(g * __builtin_amdgcn_rcpf(1.f + __builtin_amdgcn_exp2f(g * -1.4426950408889634f)) * u); }
            *(half4*)(ea.out + row * DFF + f0) = o;
          }
        }
        SCHED;
      }
    if (!has_next) break;
#pragma unroll
    for (int a = 0; a < 2; ++a)
#pragma unroll
      for (int b = 0; b < 2; ++b)
#pragma unroll
        for (int m = 0; m < 4; ++m)
#pragma unroll
          for (int n = 0; n < 2; ++n) acc[a][b][m][n] = (f32x4){0.f, 0.f, 0.f, 0.f};
    L = Ln; brow = nbrow; bcol = nbcol; cA = nA; cB = nB;
    if (wr == 1) BAR;
  }
  WAIT_V(0);
  BAR;
#undef SA
#undef SB
#undef STAGE
#undef LDA
#undef LDB
#undef MMA
#undef TILE_RC
}

DI int t5_bucket(int n) {
  if (n < 16) return n;
  int v = 16 + (int)(logf((float)n / 16.f) / 2.0794415416798357f * 16.f);
  return v > 31 ? 31 : v;
}

DI void prologue(const Params& p, const int wid_s) {
  const int tid = opaque_tid(wid_s);
  {
    const size_t n8 = (size_t)MTOK * 1024 / 8;
    half8* xa = (half8*)(p.ws + OFF_XA);
    const float4* xs = (const float4*)p.x;
    for (size_t i = (size_t)blockIdx.x * 512 + tid; i < n8; i += (size_t)gridDim.x * 512) {
      const f32x4 a = __builtin_nontemporal_load((const f32x4*)xs + 2 * i), b = __builtin_nontemporal_load((const f32x4*)xs + 2 * i + 1);
      half8 v = {(h16)a[0], (h16)a[1], (h16)a[2], (h16)a[3], (h16)b[0], (h16)b[1], (h16)b[2], (h16)b[3]};
      xa[i] = v;
    }
  }
  {
    const int wave = tid >> 6, lane = tid & 63;
    h16* tile = (h16*)smem + wave * (64 * 66);
    constexpr int PER_LAYER = 3074;
    for (int task = blockIdx.x * 8 + wave; task < 2 * PER_LAYER; task += gridDim.x * 8) {
      const int l = task / PER_LAYER; int r = task % PER_LAYER;
      const float* src0; const float* src1 = nullptr; int ld, K, kind, ntk; h16* dst;
      if (r < 640) { kind = 0; src0 = p.w_in + (size_t)l * 1024 * DIN; ld = DIN; K = 1024; dst = (h16*)(p.ws + OFF_WIN + l * SZ_WIN); }
      else if (r < 896) { r -= 640; kind = 1; src0 = p.w_out + (size_t)l * 1024 * 1024; ld = 1024; K = 1024; dst = (h16*)(p.ws + OFF_WOUT + l * SZ_WOUT); }
      else if (r < 2304) { r -= 896; kind = 2; src0 = p.w_gate + (size_t)l * 1024 * DFF; src1 = p.w_up + (size_t)l * 1024 * DFF; ld = DFF; K = 1024; dst = (h16*)(p.ws + OFF_WGU + l * SZ_WGU); }
      else if (r < 3008) { r -= 2304; kind = 1; src0 = p.w_down + (size_t)l * DFF * 1024; ld = 1024; K = DFF; dst = (h16*)(p.ws + OFF_WDN + l * SZ_WDN); }
      else if (r < 3072) { r -= 3008; const int kv = r / 32; r = r % 32; kind = 1; src0 = p.cmp_w1 + (size_t)(l * 2 + kv) * 2048 * 64; ld = 64; K = 2048; dst = (h16*)(p.ws + OFF_W1T) + (size_t)(l * 2 + kv) * 64 * 2048; }
      else { r -= 3072; const int kv = r; r = 0; kind = 1; src0 = p.cmp_w2 + (size_t)(l * 2 + kv) * 64 * 64; ld = 64; K = 64; dst = (h16*)(p.ws + OFF_W2T) + (size_t)(l * 2 + kv) * 64 * 64; }
      ntk = K / 64;
      const int n0 = (r / ntk) * 64, k0 = (r % ntk) * 64;
#pragma unroll 4
      for (int i = 0; i < 16; ++i) {
        const int kk = i * 4 + (lane >> 4), nn = (lane & 15) * 4, n = n0 + nn;
        float4 v = make_float4(0.f, 0.f, 0.f, 0.f);
        if (kind == 0) { if (n < DIN) v = *(const float4*)(src0 + (size_t)(k0 + kk) * ld + n); }
        else if (kind == 1) v = *(const float4*)(src0 + (size_t)(k0 + kk) * ld + n);
        else { const int G = n >> 5, vv = n & 31, f = 16 * G + 4 * (vv >> 3), which = (vv >> 2) & 1; v = *(const float4*)((which ? src1 : src0) + (size_t)(k0 + kk) * ld + f); }
        h16* tp = tile + kk * 66 + nn;
        tp[0] = (h16)v.x; tp[1] = (h16)v.y; tp[2] = (h16)v.z; tp[3] = (h16)v.w;
      }
      asm volatile("s_waitcnt lgkmcnt(0)" ::: "memory");
      __builtin_amdgcn_wave_barrier();
#pragma unroll 2
      for (int i = 0; i < 8; ++i) {
        const int nn = i * 8 + (lane >> 3), k8 = (lane & 7) * 8; half8 o;
#pragma unroll
        for (int j = 0; j < 8; ++j) o[j] = tile[(k8 + j) * 66 + nn];
        *(half8*)(dst + (size_t)(n0 + nn) * K + k0 + k8) = o;
      }
      asm volatile("s_waitcnt lgkmcnt(0)" ::: "memory");
      __builtin_amdgcn_wave_barrier();
    }
  }
  {
    h16* pe = (h16*)(p.ws + OFF_PE);
    for (int i = blockIdx.x * 512 + tid; i < 4 * 32 * 64; i += gridDim.x * 512) pe[i] = (h16)p.cmp_pe[i];
    float* tab = (float*)(p.ws + OFF_TAB);
    for (int i = blockIdx.x * 512 + tid; i < 8 * 132; i += gridDim.x * 512) {
      const int hh = i / 132, d = i % 132;
      tab[i] = (p.rel_bias[t5_bucket(d > 128 ? 128 : d) * 8 + hh] - p.rel_bias[31 * 8 + hh]) * 1.4426950408889634f;
    }
  }
}

DI void ln_phase(const int wid_s, const h16* __restrict__ y, const float* __restrict__ g, const float* __restrict__ b, h16* __restrict__ o16, float* __restrict__ o32) {
  const int tid_ = opaque_tid(wid_s); const int wave = tid_ >> 6, lane = tid_ & 63;
  float gg[16], bb[16];
#pragma unroll
  for (int c = 0; c < 2; ++c)
#pragma unroll
    for (int j = 0; j < 8; ++j) { gg[c * 8 + j] = g[c * 512 + lane * 8 + j]; bb[c * 8 + j] = b[c * 512 + lane * 8 + j]; }
  for (int row0 = (blockIdx.x * 8 + wave) * 2; row0 < MTOK; row0 += gridDim.x * 16) {
    half8 a0[2], a1[2];
#pragma unroll
    for (int rr = 0; rr < 2; ++rr) { const h16* yr = y + (size_t)(row0 + rr) * 1024; a0[rr] = __builtin_nontemporal_load((const half8*)(yr + lane * 8)); a1[rr] = __builtin_nontemporal_load((const half8*)(yr + 512 + lane * 8)); }
#pragma unroll
    for (int rr = 0; rr < 2; ++rr) {
      const int row = row0 + rr;
      float v[16];
#pragma unroll
      for (int j = 0; j < 8; ++j) { v[j] = (float)a0[rr][j]; v[8 + j] = (float)a1[rr][j]; }
      float s = 0.f;
#pragma unroll
      for (int j = 0; j < 16; ++j) s += v[j];
#pragma unroll
      for (int o = 32; o >= 1; o >>= 1) s += lane_get(s, lane ^ o);
      const float mu = s * (1.f / 1024.f);
      float q = 0.f;
#pragma unroll
      for (int j = 0; j < 16; ++j) { const float d = v[j] - mu; q += d * d; }
#pragma unroll
      for (int o = 32; o >= 1; o >>= 1) q += lane_get(q, lane ^ o);
      const float rs = rsqrtf(q * (1.f / 1024.f) + 1e-5f);
      float r[16];
#pragma unroll
      for (int j = 0; j < 16; ++j) r[j] = (v[j] - mu) * rs * gg[j] + bb[j];
      half8 o0, o1;
#pragma unroll
      for (int j = 0; j < 8; ++j) { o0[j] = (h16)r[j]; o1[j] = (h16)r[8 + j]; }
      if (o16) {
        *(half8*)(o16 + (size_t)row * 1024 + lane * 8) = o0;
        *(half8*)(o16 + (size_t)row * 1024 + 512 + lane * 8) = o1;
      }
      if (o32) {
        float* orow = o32 + (size_t)row * 1024;
        __builtin_nontemporal_store((f32x4){r[0], r[1], r[2], r[3]}, (f32x4*)(orow + lane * 8));
        __builtin_nontemporal_store((f32x4){r[4], r[5], r[6], r[7]}, (f32x4*)(orow + lane * 8 + 4));
        __builtin_nontemporal_store((f32x4){r[8], r[9], r[10], r[11]}, (f32x4*)(orow + 512 + lane * 8));
        __builtin_nontemporal_store((f32x4){r[12], r[13], r[14], r[15]}, (f32x4*)(orow + 512 + lane * 8 + 4));
      }
    }
  }
}

DI float gelu_tanh(float x) {
  const float u = 0.7978845608028654f * (x + 0.044715f * x * x * x);
  const float t = __expf(2.f * u);
  const float th = 1.f - 2.f / (t + 1.f);
  return 0.5f * x * (1.f + th);
}

DI void mixers_phase(const Params& p, const int l, const int wid_s) {
  const int tid = opaque_tid(wid_s), wave = tid >> 6, lane = tid & 63, fr = lane & 15, fq = lane >> 4;
  const h16* h = (const h16*)(p.ws + OFF_H);
  h16* mix = (h16*)(p.ws + OFF_MIX);
  h16* kc = (h16*)(p.ws + OFF_KC);
  h16* vcT = (h16*)(p.ws + OFF_VCT);
  for (int i = blockIdx.x * 512 + tid; i < 64 * 64; i += gridDim.x * 512) {
    const int bg = i >> 6, d = i & 63;
    kc[((size_t)bg * 128 + 127) * 64 + d] = (h16)0.f;
    vcT[(((size_t)bg * 4 + 3) * 64 + d) * 32 + 31] = (h16)0.f;
  }
  {
    const int tsk = (wave & 3) * gridDim.x + blockIdx.x, half = wave >> 2;
    const bool act = tsk < 1016;
    const int kv = act ? tsk / 508 : 0, rt = act ? tsk % 508 : 0;
    const int r = rt * 16 + fr, bg = r / 127, n = r % 127, b = bg >> 1, g = bg & 1;
    f32x4 a1[4];
#pragma unroll
    for (int e = 0; e < 4; ++e) a1[e] = (f32x4){0.f, 0.f, 0.f, 0.f};
    if (act) {
      const h16* zb = h + ((size_t)b * SEQ + n * 16) * LDH + (kv ? C_VC : C_KC) + g * 64;
      const h16* pe = (const h16*)(p.ws + OFF_PE) + (size_t)(l * 2 + kv) * 32 * 64;
      const h16* w1t = (const h16*)(p.ws + OFF_W1T) + (size_t)(l * 2 + kv) * 64 * 2048;
#pragma unroll 4
      for (int s = half * 32; s < half * 32 + 32; ++s) {
        const int i = s >> 1, d = (s & 1) * 32 + fq * 8;
        half8 zf = *(const half8*)(zb + (size_t)i * LDH + d);
        const half8 pf = *(const half8*)(pe + i * 64 + d);
        zf = zf + pf;
#pragma unroll
        for (int e = 0; e < 4; ++e) {
          const half8 wf = *(const half8*)(w1t + (size_t)(e * 16 + fr) * 2048 + s * 32 + fq * 8);
          a1[e] = MFMA16(wf, zf, a1[e]);
        }
      }
    }
    float* red = (float*)smem + (wave & 3) * (16 * 64) + lane;
    if (act && half == 1) {
#pragma unroll
      for (int e = 0; e < 4; ++e)
#pragma unroll
        for (int j = 0; j < 4; ++j) red[(e * 4 + j) * 64] = a1[e][j];
    }
    __syncthreads();
    if (act && half == 0) {
#pragma unroll
      for (int e = 0; e < 4; ++e)
#pragma unroll
        for (int j = 0; j < 4; ++j) a1[e][j] += red[(e * 4 + j) * 64];
      const h16* w2t = (const h16*)(p.ws + OFF_W2T) + (size_t)(l * 2 + kv) * 64 * 64;
      f32x4 a2[4];
#pragma unroll
      for (int d = 0; d < 4; ++d) a2[d] = (f32x4){0.f, 0.f, 0.f, 0.f};
#pragma unroll
      for (int s2 = 0; s2 < 2; ++s2) {
        half8 gf;
#pragma unroll
        for (int j = 0; j < 4; ++j) { gf[j] = (h16)gelu_tanh(a1[2 * s2][j]); gf[4 + j] = (h16)gelu_tanh(a1[2 * s2 + 1][j]); }
#pragma unroll
        for (int dt = 0; dt < 4; ++dt) {
          const half4 w0 = *(const half4*)(w2t + (dt * 16 + fr) * 64 + 32 * s2 + fq * 4);
          const half4 w1 = *(const half4*)(w2t + (dt * 16 + fr) * 64 + 32 * s2 + 16 + fq * 4);
          const half8 wf = __builtin_shufflevector(w0, w1, 0, 1, 2, 3, 4, 5, 6, 7);
          a2[dt] = MFMA16(wf, gf, a2[dt]);
        }
      }
      if (kv == 0) {
#pragma unroll
        for (int dt = 0; dt < 4; ++dt) {
          half4 o = {(h16)a2[dt][0], (h16)a2[dt][1], (h16)a2[dt][2], (h16)a2[dt][3]};
          *(half4*)(kc + ((size_t)bg * 128 + n) * 64 + dt * 16 + fq * 4) = o;
        }
      } else {
#pragma unroll
        for (int dt = 0; dt < 4; ++dt)
#pragma unroll
          for (int j = 0; j < 4; ++j) { const int ko = n & 31, pos = ko < 16 ? ((ko >> 2) * 8 + (ko & 3)) : (((ko - 16) >> 2) * 8 + 4 + (ko & 3));
            vcT[(((size_t)bg * 4 + (n >> 5)) * 64 + dt * 16 + fq * 4 + j) * 32 + pos] = (h16)a2[dt][j]; }
      }
    }
    __syncthreads();
  }
  for (int rp_12 = 0; rp_12 < (((p.probe_mask >> 12) & 1) ? 2 : 1); ++rp_12) {
  {
    const float* cw = p.conv_w + (size_t)l * 3 * 256;
    const int c8 = (tid & 31) * 8;
    float w0[8], w1[8], w2[8];
#pragma unroll
    for (int j = 0; j < 8; ++j) { w0[j] = cw[c8 + j]; w1[j] = cw[256 + c8 + j]; w2[j] = cw[512 + c8 + j]; }
    for (int quad = blockIdx.x * 16 + (tid >> 5); quad < MTOK / 4; quad += gridDim.x * 16) {
      const int row0 = quad * 4, t0 = row0 & (SEQ - 1);
      const h16* hr = h + (size_t)row0 * LDH;
      half8 cg[6], xg[6], bgv[4];
#pragma unroll
      for (int i = 0; i < 6; ++i) {
        if (i >= 2 || t0 > 0) { cg[i] = *(const half8*)(hr + (i - 2) * LDH + C_CG + c8); xg[i] = *(const half8*)(hr + (i - 2) * LDH + C_XC + c8); }
        else {
#pragma unroll
          for (int j = 0; j < 8; ++j) { cg[i][j] = (h16)0.f; xg[i][j] = (h16)0.f; }
        }
      }
#pragma unroll
      for (int i = 0; i < 4; ++i) bgv[i] = *(const half8*)(hr + i * LDH + C_BG + c8);
      float u[6][8];
#pragma unroll
      for (int i = 0; i < 6; ++i)
#pragma unroll
        for (int j = 0; j < 8; ++j) u[i][j] = (float)cg[i][j] * (float)xg[i][j];
#pragma unroll
      for (int i = 0; i < 4; ++i) {
        half8 o;
#pragma unroll
        for (int j = 0; j < 8; ++j) o[j] = (h16)((float)bgv[i][j] * (w0[j] * u[i][j] + w1[j] * u[i + 1][j] + w2[j] * u[i + 2][j]));
        *(half8*)(mix + (size_t)(row0 + i) * 1024 + c8) = o;
      }
    }
  }
  }
  for (int rp_13 = 0; rp_13 < (((p.probe_mask >> 13) & 1) ? 2 : 1); ++rp_13) {
    constexpr int UST = 264, WST = 72;
    h16* ul = (h16*)smem;
    h16* wt = (h16*)smem + 143 * UST;
    const float* pw = p.pool_w + (size_t)l * 4 * 64 * 64;
    const float* psc = p.pool_scale + (size_t)l * 256;
    __syncthreads();
    for (int i = tid; i < 4 * 64 * 64; i += 512) { const int gc = i >> 6, dd = i & 63, gi = gc >> 6, c = gc & 63; wt[(gi * 64 + dd) * WST + c] = (h16)pw[i]; }
    for (int tile = blockIdx.x; tile < MTOK / 128; tile += gridDim.x) {
      const int row0 = tile * 128, t0 = row0 & (SEQ - 1);
      for (int e = tid; e < 143 * 32; e += 512) {
        const int rr = e >> 5, ch = (e & 31) * 8, t = t0 - 15 + rr;
        half8 v;
#pragma unroll
        for (int j = 0; j < 8; ++j) v[j] = (h16)0.f;
        if (t >= 0) v = *(const half8*)(h + (size_t)(row0 - 15 + rr) * LDH + C_XP + ch);
        *(half8*)(ul + rr * UST + ch) = v;
      }
      __syncthreads();
      {
        const int tok = wave * 16 + fr, t = t0 + tok;
        const h16* ub = ul + (15 + tok) * UST;
#pragma unroll
        for (int gi = 0; gi < 4; ++gi) {
          const int w = 2 << gi;
          const float rc = 1.f / (float)((t + 1) < w ? (t + 1) : w);
          half8 bd[2];
#pragma unroll
          for (int ks = 0; ks < 2; ++ks) {
            const h16* up = ub + gi * 64 + ks * 32 + fq * 8;
            const half8 u0 = *(const half8*)up;
            float s[8];
#pragma unroll
            for (int j = 0; j < 8; ++j) s[j] = (float)u0[j];
#pragma unroll
            for (int i = 1; i < w; ++i) { const half8 ui = *(const half8*)(up - i * UST);
#pragma unroll
              for (int j = 0; j < 8; ++j) s[j] += (float)ui[j]; }
#pragma unroll
            for (int j = 0; j < 8; ++j) bd[ks][j] = (h16)(s[j] * rc - (float)u0[j]);
          }
          f32x4 o[4];
#pragma unroll
          for (int dt = 0; dt < 4; ++dt) {
            o[dt] = (f32x4){0.f, 0.f, 0.f, 0.f};
#pragma unroll
            for (int ks = 0; ks < 2; ++ks) {
              const half8 wf = *(const half8*)(wt + (gi * 64 + dt * 16 + fr) * WST + ks * 32 + fq * 8);
              o[dt] = MFMA16(wf, bd[ks], o[dt]);
            }
          }
#pragma unroll
          for (int dt = 0; dt < 4; ++dt) {
            const f32x4 sc = *(const f32x4*)(psc + gi * 64 + dt * 16 + fq * 4);
            half4 ov = {(h16)(o[dt][0] * sc[0]), (h16)(o[dt][1] * sc[1]), (h16)(o[dt][2] * sc[2]), (h16)(o[dt][3] * sc[3])};
            *(half4*)(mix + (size_t)(row0 + tok) * 1024 + 768 + gi * 64 + dt * 16 + fq * 4) = ov;
          }
        }
      }
      __syncthreads();
    }
  }
  for (int rp_14 = 0; rp_14 < (((p.probe_mask >> 14) & 1) ? 2 : 1); ++rp_14) {
  {
    unsigned* kmx = (unsigned*)(p.ws + OFF_KMAX) + l * 128;
    for (int task = blockIdx.x * 8 + wave; task < 8192; task += gridDim.x * 8) {
      const int ts = task >> 12, rem = task & 4095, bg = rem >> 6, st = rem & 63, b = bg >> 1, g = bg & 1;
      const h16* src = h + ((size_t)b * SEQ + st * 32) * LDH + (ts ? C_KW : C_KS) + g * 64;
      float n2 = 0.f;
#pragma unroll
      for (int kt = 0; kt < 2; ++kt) {
        float a = 0.f;
#pragma unroll
        for (int ks = 0; ks < 2; ++ks) {
          const half8 v = *(const half8*)(src + (size_t)(kt * 16 + fr) * LDH + ks * 32 + fq * 8);
#pragma unroll
          for (int j = 0; j < 8; ++j) a += (float)v[j] * (float)v[j];
        }
        a += lane_get(a, lane ^ 16); a += lane_get(a, lane ^ 32);
        n2 = fmaxf(n2, a);
      }
#pragma unroll
      for (int o = 1; o <= 8; o <<= 1) n2 = fmaxf(n2, lane_get(n2, lane ^ o));
      if (lane == 0) atomicMax(kmx + ts * 64 + bg, __float_as_uint(n2));
    }
  }
  {
    h16* tl = (h16*)smem + wave * (64 * 72);
    for (int task = blockIdx.x * 8 + wave; task < 4096; task += gridDim.x * 8) {
      const int ts = task >> 11, rem = task & 2047, bg = rem >> 5, tt = rem & 31, b = bg >> 1, g = bg & 1;
      const h16* src = h + ((size_t)b * SEQ + tt * 64) * LDH + (ts ? C_VW : C_VS) + g * 64;
      h16* dst = (h16*)(p.ws + (ts ? OFF_VWT : OFF_VST)) + ((size_t)bg * 64 + tt * 2) * 64 * 32;
#pragma unroll
      for (int i = 0; i < 8; ++i) { const int tk = i * 8 + (lane >> 3), ch = lane & 7; *(half8*)(tl + tk * 72 + ch * 8) = *(const half8*)(src + (size_t)tk * LDH + ch * 8); }
      asm volatile("s_waitcnt lgkmcnt(0)" ::: "memory");
      __builtin_amdgcn_wave_barrier();
#pragma unroll
      for (int i = 0; i < 8; ++i) {
        const int e = i * 64 + lane, d = e >> 3, tch = e & 7, sp = tch >> 2, f4 = tch & 3; half8 o;
#pragma unroll
        for (int j = 0; j < 4; ++j) { o[j] = tl[(sp * 32 + f4 * 4 + j) * 72 + d]; o[4 + j] = tl[(sp * 32 + 16 + f4 * 4 + j) * 72 + d]; }
        *(half8*)(dst + ((size_t)sp * 64 + d) * 32 + f4 * 8) = o;
      }
      asm volatile("s_waitcnt lgkmcnt(0)" ::: "memory");
      __builtin_amdgcn_wave_barrier();
    }
  }
  }
}

DI float fmax_nc(float a, float b) { return __builtin_amdgcn_fmed3f(a, b, __builtin_inff()); }
DI float red4_max(float v, int lane) {
  const unsigned u = __float_as_uint(v);
  const auto r = __builtin_amdgcn_permlane16_swap(u, u, false, false);
  const float w = fmax_nc(__uint_as_float(r[0]), __uint_as_float(r[1]));
  const unsigned x = __float_as_uint(w);
  const auto s = __builtin_amdgcn_permlane32_swap(x, x, false, false);
  return fmax_nc(__uint_as_float(s[0]), __uint_as_float(s[1]));
}
DI float red4_sum(float v, int lane) { v += lane_get(v, lane ^ 16); v += lane_get(v, lane ^ 32); return v; }

typedef float f32x2 __attribute__((ext_vector_type(2)));
constexpr float M_INIT = -1e20f, MASKV = -1e30f;
DI float max8(const f32x4 a, const f32x4 b) { return fmax_nc(fmax_nc(fmax_nc(a[0], a[1]), fmax_nc(a[2], a[3])), fmax_nc(fmax_nc(b[0], b[1]), fmax_nc(b[2], b[3]))); }
DI half8 pack8(const f32x4 a, const f32x4 b) {
  typedef __fp16 fp16x2 __attribute__((ext_vector_type(2)));
  union { fp16x2 h[4]; half8 v; } u;
  u.h[0] = __builtin_amdgcn_cvt_pkrtz(a[0], a[1]); u.h[1] = __builtin_amdgcn_cvt_pkrtz(a[2], a[3]);
  u.h[2] = __builtin_amdgcn_cvt_pkrtz(b[0], b[1]); u.h[3] = __builtin_amdgcn_cvt_pkrtz(b[2], b[3]);
  return u.v;
}
struct KF { half8 k[2][2]; half8 v[4]; };
DI void load_k(KF& r, const h16* __restrict__ kbase, const h16* __restrict__ vT, const int kb, const unsigned koff, const unsigned voff) {
  const char* ku = (const char*)kbase + (size_t)kb * (LDH * 2);
  const char* vu = (const char*)vT + (size_t)(kb >> 5) * (64 * 32 * 2);
#pragma unroll
  for (int kt = 0; kt < 2; ++kt)
#pragma unroll
    for (int ks = 0; ks < 2; ++ks) r.k[kt][ks] = *(const half8*)(ku + (size_t)kt * (16 * LDH * 2) + ks * 64 + koff);
#pragma unroll
  for (int dt = 0; dt < 4; ++dt) r.v[dt] = *(const half8*)(vu + dt * (16 * 32 * 2) + voff);
}

template <bool SEL, bool GEN>
DI void attn_step(const KF& kv, const int kb, const int t, const int lane, const bool selbit,
                  const LAS float* tabh, const half8 (&q)[2][2], f32x4 (&O)[2][4], const float (&nR)[2], float (&l)[2]) {
  const int fq = lane >> 4;
  f32x4 s[2][2];
#pragma unroll
  for (int hp = 0; hp < 2; ++hp) {
    float nm = nR[hp];
    if (SEL) nm = selbit ? nm : MASKV;
    const f32x4 c0 = {nm, nm, nm, nm};
#pragma unroll
    for (int kt = 0; kt < 2; ++kt) {
      s[hp][kt] = MFMA16(kv.k[kt][0], q[hp][0], c0);
      s[hp][kt] = MFMA16(kv.k[kt][1], q[hp][1], s[hp][kt]);
    }
  }
  if (GEN) {
    const int d0 = t - kb - fq * 4;
#pragma unroll
    for (int kt = 0; kt < 2; ++kt)
#pragma unroll
      for (int j = 0; j < 4; ++j) {
        const int dist = d0 - (kt * 16 + j);
        const bool bad = SEL ? (dist < 0) : ((unsigned)dist >= 512u);
        const int ix = bad ? 130 : (dist > 128 ? 128 : dist);
#pragma unroll
        for (int hp = 0; hp < 2; ++hp) s[hp][kt][j] += tabh[hp * 132 + ix];
      }
  }
  half8 pf[2];
#pragma unroll
  for (int hp = 0; hp < 2; ++hp) {
    f32x4 p0, p1;
#pragma unroll
    for (int j = 0; j < 4; ++j) { p0[j] = __builtin_amdgcn_exp2f(s[hp][0][j]); p1[j] = __builtin_amdgcn_exp2f(s[hp][1][j]); }
    l[hp] += ((p0[0] + p0[1]) + (p0[2] + p0[3])) + ((p1[0] + p1[1]) + (p1[2] + p1[3]));
    pf[hp] = pack8(p0, p1);
  }
#pragma unroll
  for (int dt = 0; dt < 4; ++dt)
#pragma unroll
    for (int hp = 0; hp < 2; ++hp) O[hp][dt] = MFMA16(kv.v[dt], pf[hp], O[hp][dt]);
}

DI void attn_phase(const Params& p, const int layer, const int wid_s) {
  const int tid = opaque_tid(wid_s), wave = __builtin_amdgcn_readfirstlane(tid >> 6), lane = tid & 63, fr = lane & 15, fq = lane >> 4;
  const unsigned koff = (unsigned)(fr * LDH + fq * 8) * 2u, voff = (unsigned)(fr * 32 + fq * 8) * 2u;
  LAS float* tab = (LAS float*)smem;
  LAS float* impb = (LAS float*)((LAS unsigned char*)smem + 4224) + wave * 576 + fr * 36;
  LAS float* impx = (LAS float*)((LAS unsigned char*)smem + 4224 + 18432) + lane;
  LAS float* fin = (LAS float*)((LAS unsigned char*)smem + 4224 + 18432 + 16384) + wave * 2048 + lane;
  {
    const float* tg = (const float*)(p.ws + OFF_TAB);
    for (int i = tid; i < 8 * 132; i += 512) tab[i] = tg[i];
  }
  __syncthreads();
  if (tid < 8) { float bm = 0.f; for (int i = 0; i <= 128; ++i) bm = fmaxf(bm, tab[tid * 132 + i]); tab[tid * 132 + 129] = bm; tab[tid * 132 + 130] = MASKV; }
  __syncthreads();
  const h16* h = (const h16*)(p.ws + OFF_H);
  h16* mix = (h16*)(p.ws + OFF_MIX);
  const int nunits = BATCH * 2 * 32;
  const int hpair = wave >> 2;
  for (int it = 0; it * (int)gridDim.x < nunits; ++it) {
    const int vb = vbid();
    const int uid = it * (int)gridDim.x + vb;
    const bool active = uid < nunits;
    int bg, q0;
    if (gridDim.x == 256) { bg = it * 8 + (vb & 7); q0 = vb >> 3; } else { bg = uid >> 5; q0 = uid & 31; }
    if (!active) { bg = 0; q0 = 0; }
    const int qblk = (it & 1) ? 31 - q0 : q0;
    const int b = bg >> 1, g = bg & 1;
    const int t0 = qblk * 64 + (wave & 3) * 16, t = t0 + fr, cur = qblk;
    const int hh0 = g * 4 + hpair * 2;
    const h16* hb = h + (size_t)b * SEQ * LDH;
    const LAS float* tabh = tab + hh0 * 132;
    half8 q[2][2];
#pragma unroll
    for (int hp = 0; hp < 2; ++hp)
#pragma unroll
      for (int ks = 0; ks < 2; ++ks) {
        half8 qq = *(const half8*)(hb + (size_t)t * LDH + C_Q + (hh0 + hp) * 64 + ks * 32 + fq * 8);
        q[hp][ks] = qq * (h16)0.18033688011112042f;
      }
    float gate[2][3];
#pragma unroll
    for (int hp = 0; hp < 2; ++hp)
#pragma unroll
      for (int br = 0; br < 3; ++br) {
        const float gl = (float)hb[(size_t)t * LDH + C_GL + (hh0 + hp) * 3 + br];
        gate[hp][br] = 1.f / (1.f + __expf(-gl));
      }
    unsigned selmask;
    {
      int fql = fq; asm volatile("" : "+v"(fql));
      const int dbase = t - 31 - fql * 64;
      const h16* kcb = (const h16*)(p.ws + OFF_KC) + (size_t)bg * 128 * 64;
      const h16* vcb = (const h16*)(p.ws + OFF_VCT) + (size_t)bg * 64 * 128;
      half8 kc0[8], kc1[8];
#pragma unroll
      for (int nt = 0; nt < 8; ++nt) {
        if (nt * 256 > t0 - 16) { kc0[nt] = (half8){0, 0, 0, 0, 0, 0, 0, 0}; kc1[nt] = kc0[nt]; }
        else { kc0[nt] = *(const half8*)(kcb + (nt * 16 + fr) * 64 + fq * 8); kc1[nt] = *(const half8*)(kcb + (nt * 16 + fr) * 64 + 32 + fq * 8); }
      }
#pragma unroll
      for (int hp = 0; hp < 2; ++hp) {
        half8 qc[2];
#pragma unroll
        for (int ks = 0; ks < 2; ++ks) qc[ks] = hp ? q[1][ks] : q[0][ks];
        const float gate_c = hp ? gate[1][0] : gate[0][0];
        f32x4 s[8];
        float mx = M_INIT;
#pragma unroll
        for (int nt = 0; nt < 8; ++nt) {
          const bool tinv = nt * 256 > t0 - 16, tfar = nt * 256 + 399 <= t0;
          if (tinv) { s[nt] = (f32x4){MASKV, MASKV, MASKV, MASKV}; }
          else {
            s[nt] = MFMA16(kc0[nt], qc[0], ((f32x4){0.f, 0.f, 0.f, 0.f}));
            s[nt] = MFMA16(kc1[nt], qc[1], s[nt]);
            if (!tfar) {
#pragma unroll
              for (int j = 0; j < 4; ++j) {
                const int dist = dbase - (nt * 256 + j * 16);
                const int ix = dist < 0 ? 0 : (dist > 128 ? 128 : dist);
                const float bv = tabh[hp * 132 + ix];
                const float sv = s[nt][j] + bv;
                s[nt][j] = dist >= 0 ? sv : MASKV;
              }
            }
            mx = fmax_nc(mx, fmax_nc(fmax_nc(s[nt][0], s[nt][1]), fmax_nc(s[nt][2], s[nt][3])));
          }
        }
        mx = red4_max(mx, lane);
        float ps = 0.f;
#pragma unroll
        for (int nt = 0; nt < 8; ++nt) {
          const bool tinv = nt * 256 > t0 - 16;
          if (tinv) { s[nt] = (f32x4){0.f, 0.f, 0.f, 0.f}; }
          else {
#pragma unroll
            for (int j = 0; j < 4; ++j) { const float pv = __builtin_amdgcn_exp2f(s[nt][j] - mx); ps += pv; s[nt][j] = pv; }
          }
        }
        ps = red4_sum(ps, lane);
        const float inv = ps > 0.f ? 1.f / ps : 0.f;
#pragma unroll
        for (int nt = 0; nt < 8; ++nt) s[nt] = s[nt] * inv;
        if (cur >= 8)
#pragma unroll
        for (int nt = 0; nt < 8; ++nt) {
          const float x1 = lane_get(s[nt][3], (lane - 16) & 63);
          const float x2 = nt > 0 ? lane_get(s[nt > 0 ? nt - 1 : 0][3], (lane - 16) & 63) : 0.f;
          const float left = fq > 0 ? x1 : x2;
          const float im = left + 2.f * (s[nt][0] + s[nt][1] + s[nt][2]) + s[nt][3];
          LAS float* ip = impx + (wave * 8 + nt) * 64;
          if (hp == 0) *ip = im; else *ip += im;
        }
        f32x4 o[4];
#pragma unroll
        for (int dt = 0; dt < 4; ++dt) o[dt] = (f32x4){0.f, 0.f, 0.f, 0.f};
#pragma unroll
        for (int st = 0; st < 4; ++st) {
          if (2 * st * 256 > t0 - 16) continue;
          const half8 pf = {(h16)s[2 * st][0], (h16)s[2 * st][1], (h16)s[2 * st][2], (h16)s[2 * st][3],
                            (h16)s[2 * st + 1][0], (h16)s[2 * st + 1][1], (h16)s[2 * st + 1][2], (h16)s[2 * st + 1][3]};
#pragma unroll
          for (int dt = 0; dt < 4; ++dt) {
            const half8 vf = *(const half8*)(vcb + ((st * 64) + dt * 16 + fr) * 32 + fq * 8);
            o[dt] = MFMA16(vf, pf, o[dt]);
          }
        }
#pragma unroll
        for (int dt = 0; dt < 4; ++dt)
#pragma unroll
          for (int j = 0; j < 4; ++j) fin[(hp * 16 + dt * 4 + j) * 64] = o[dt][j] * gate_c;
      }
      unsigned mk = (2u << cur) - 1u;
      if (cur >= 8) {
      float impv[8];
      __syncthreads();
#pragma unroll
      for (int nt = 0; nt < 8; ++nt) {
        const float mine = impx[(wave * 8 + nt) * 64], other = impx[((wave ^ 4) * 8 + nt) * 64];
        const float im = hpair == 0 ? mine + other : other + mine;
        const int jb = nt * 4 + fql;
        const bool forced = (jb == 0) || (jb == cur) || (jb == cur - 1);
        impv[nt] = jb <= cur ? im + (forced ? 1e6f : 0.f) : NEGF;
        impb[jb] = impv[nt];
      }
      __syncthreads();
      int cnt[8];
#pragma unroll
      for (int nt = 0; nt < 8; ++nt) cnt[nt] = 0;
#pragma unroll
      for (int i = 0; i < 8; ++i) {
        const f32x4 r4 = *(const LAS f32x4*)(impb + 4 * i);
        const float rv[4] = {r4[0], r4[1], r4[2], r4[3]};
#pragma unroll
        for (int nt = 0; nt < 8; ++nt) {
          const float a = impv[nt]; const int ja = nt * 4 + fql;
#pragma unroll
          for (int c = 0; c < 4; ++c) cnt[nt] += (int)(rv[c] > a) | ((int)(rv[c] == a) & (int)((4 * i + c) < ja));
        }
      }
      mk = 0;
#pragma unroll
      for (int nt = 0; nt < 8; ++nt) { const int ja = nt * 4 + fql; if (cnt[nt] < 8 && ja <= cur) mk |= 1u << ja; }
      mk |= (unsigned)lane_get_i((int)mk, lane ^ 16);
      mk |= (unsigned)lane_get_i((int)mk, lane ^ 32);
      }
      selmask = mk;
    }
    if (!active) continue;
    float nRs[2], nRw[2];
    {
      const float* kmx = (const float*)(p.ws + OFF_KMAX) + layer * 128;
      const float k2s = kmx[bg], k2w = kmx[64 + bg];
#pragma unroll
      for (int hp = 0; hp < 2; ++hp) {
        float q2 = 0.f;
#pragma unroll
        for (int ks = 0; ks < 2; ++ks)
#pragma unroll
          for (int j = 0; j < 8; ++j) q2 += (float)q[hp][ks][j] * (float)q[hp][ks][j];
        q2 = red4_sum(q2, lane);
        const float bm = tabh[hp * 132 + 129];
        nRs[hp] = 12.f - (sqrtf(q2 * k2s) * 1.002f + 0.01f + bm);
        nRw[hp] = 12.f - (sqrtf(q2 * k2w) * 1.002f + 0.01f + bm);
      }
    }
    {
      LAS unsigned char* ring = (LAS unsigned char*)smem + 104576;
      int k_src_off, v_src_off;
      { const int r = tid >> 3, cs = tid & 7, c = cs ^ (r & 7); k_src_off = r * LDH + c * 8; }
      { const int i = tid & 255, r = i >> 2, cs = i & 3, c = cs ^ ((r >> 2) & 3); v_src_off = r * 32 + c * 8; }
      const unsigned stage_dst = (unsigned)(wave < 4 ? wave * 1024 : 4096 + (wave - 4) * 1024);
      unsigned kread[2][2], vread[4];
#pragma unroll
      for (int kt = 0; kt < 2; ++kt)
#pragma unroll
        for (int ks = 0; ks < 2; ++ks) { const int r = kt * 16 + fr, c = ks * 4 + fq; kread[kt][ks] = (unsigned)(r * 128 + ((c ^ (r & 7)) * 16)); }
#pragma unroll
      for (int dt = 0; dt < 4; ++dt) { const int r = dt * 16 + fr; vread[dt] = (unsigned)(4096 + r * 64 + ((fq ^ ((r >> 2) & 3)) * 16)); }
      const int kb_last = qblk * 64 + 32;
      const int kmax_w = (t0 + 15) & ~31;
#pragma unroll 1
      for (int br = 1; br <= 2; ++br) {
        const h16* kbase = hb + (br == 1 ? C_KS : C_KW) + g * 64;
        const h16* vT = (const h16*)(p.ws + (br == 1 ? OFF_VST : OFF_VWT)) + (size_t)bg * 64 * SEQ;
        int kb0 = 0, lo_w = 0;
        if (br == 2) { kb0 = qblk * 64 - 512; if (kb0 < 0) kb0 = 0; lo_w = t0 - 511; if (lo_w < 0) lo_w = 0; lo_w &= ~31; }
        const int nsteps = (kb_last - kb0) / 32 + 1;
        f32x4 O[2][4]; float l[2];
#pragma unroll
        for (int hp = 0; hp < 2; ++hp) { l[hp] = 0.f;
#pragma unroll
          for (int dt = 0; dt < 4; ++dt) O[hp][dt] = (f32x4){0.f, 0.f, 0.f, 0.f}; }
#define RING_ISSUE(SI) do { int kbi = kb0 + (SI) * 32; if (kbi > kb_last) kbi = kb_last; const int slot = (SI) % 3; \
          const h16* srcp = wave < 4 ? kbase + (size_t)kbi * LDH + k_src_off : vT + (size_t)(kbi >> 5) * 2048 + v_src_off; \
          __builtin_amdgcn_global_load_lds((const unsigned*)srcp, (LAS unsigned*)(ring + slot * 8192 + stage_dst), 16, 0, 0); } while (0)
        asm volatile("s_waitcnt vmcnt(0)" ::: "memory");
        __syncthreads();
        RING_ISSUE(0); RING_ISSUE(1);
#pragma unroll 1
        for (int si = 0; si < nsteps; ++si) {
          asm volatile("s_waitcnt vmcnt(1) lgkmcnt(0)" ::: "memory");
          __builtin_amdgcn_s_barrier();
          asm volatile("" ::: "memory");
          RING_ISSUE(si + 2);
          const int kb = kb0 + si * 32;
          if (kb > kmax_w || kb < lo_w) continue;
          if (br == 1 && kb + 31 + 128 <= t0 && __ballot((selmask >> (kb >> 6)) & 1u) == 0ull) continue;
          LAS unsigned char* slotp = ring + (si % 3) * 8192;
          KF kv;
#pragma unroll
          for (int kt = 0; kt < 2; ++kt)
#pragma unroll
            for (int ks = 0; ks < 2; ++ks) kv.k[kt][ks] = *(const LAS half8*)(slotp + kread[kt][ks]);
#pragma unroll
          for (int dt = 0; dt < 4; ++dt) kv.v[dt] = *(const LAS half8*)(slotp + vread[dt]);
          if (br == 1) {
            const bool bit = (selmask >> (kb >> 6)) & 1u;
            if (kb + 31 + 128 <= t0) attn_step<true, false>(kv, kb, t, lane, bit, tabh, q, O, nRs, l);
            else attn_step<true, true>(kv, kb, t, lane, bit, tabh, q, O, nRs, l);
          } else {
            const bool gen = (kb + 31 + 128 > t0) || (kb + 512 <= t0 + 15);
            if (!gen) attn_step<false, false>(kv, kb, t, lane, true, tabh, q, O, nRw, l);
            else attn_step<false, true>(kv, kb, t, lane, true, tabh, q, O, nRw, l);
          }
        }
#undef RING_ISSUE
        if (br == 1) {
#pragma unroll
          for (int hp = 0; hp < 2; ++hp) {
            const float lt = red4_sum(l[hp], lane);
            const float sc = lt > 0.f ? gate[hp][1] / lt : 0.f;
#pragma unroll
            for (int dt = 0; dt < 4; ++dt)
#pragma unroll
              for (int j = 0; j < 4; ++j) fin[(hp * 16 + dt * 4 + j) * 64] += O[hp][dt][j] * sc;
          }
        } else {
          int t_late = t; asm volatile("" : "+v"(t_late));
#pragma unroll
          for (int hp = 0; hp < 2; ++hp) {
            const float lt = red4_sum(l[hp], lane);
            const float sc = lt > 0.f ? gate[hp][2] / lt : 0.f;
#pragma unroll
            for (int dt = 0; dt < 4; ++dt) {
              half4 o;
#pragma unroll
              for (int j = 0; j < 4; ++j) o[j] = (h16)(fin[(hp * 16 + dt * 4 + j) * 64] + O[hp][dt][j] * sc);
              *(half4*)(mix + ((size_t)b * SEQ + t_late) * 1024 + 256 + (hh0 + hp) * 64 + dt * 16 + fq * 4) = o;
            }
          }
        }
      }
      asm volatile("s_waitcnt vmcnt(0)" ::: "memory");
    }
  }
}

#define XB_TMO      128
#define XB_XCNT(j)  (256  + 64 * (j))
#define XB_XSUB(j)  (1280 + 64 * (j))
#define XB_XGEN(j)  (2304 + 64 * (j))
#define XB_TOP      3328
#define XB_TOPGEN   3392
#define XCD_BAR_WORDS 3456
#define XB_SPIN_CAP (1u << 22)
DI unsigned xb_ld(unsigned* p) { return __hip_atomic_load(p, __ATOMIC_RELAXED, __HIP_MEMORY_SCOPE_AGENT); }
DI unsigned xb_add(unsigned* p, unsigned v) { return __hip_atomic_fetch_add(p, v, __ATOMIC_RELAXED, __HIP_MEMORY_SCOPE_AGENT); }
DI unsigned xb_xcc_id() { return (unsigned)__builtin_amdgcn_s_getreg((3 << 11) | 20) & 0xFu; }
#define XB_SPIN(cond, bar) do { unsigned _sp = 0; while (cond) { __builtin_amdgcn_s_sleep(1); \
    if ((++_sp & 255u) == 0u) { if (xb_ld(&(bar)[XB_TMO])) break; if (_sp > XB_SPIN_CAP) { atomicAdd(&(bar)[XB_TMO], 1u); break; } } } } while (0)
struct XcdBarrier { unsigned* bar; unsigned x; volatile LAS unsigned* st; };
DI XcdBarrier xcd_barrier_post(unsigned* bar, volatile LAS unsigned* st, const bool leader) {
  XcdBarrier b; b.bar = bar; b.x = xb_xcc_id(); b.st = st;
  if (leader) { const unsigned rank = xb_add(&bar[XB_XCNT(b.x)], 1u); st[2] = rank; }
  return b;
}
DI void xcd_barrier_complete(unsigned* bar, unsigned x, unsigned& nloc, unsigned& nx) {
  const unsigned G = gridDim.x * gridDim.y * gridDim.z;
  unsigned sum, cnt, mine, sp = 0u;
  for (;;) {
    sum = 0u; cnt = 0u; mine = 0u;
#pragma unroll
    for (unsigned j = 0; j < 16; ++j) { const unsigned c = xb_ld(&bar[XB_XCNT(j)]); sum += c; cnt += (c > 0u) ? 1u : 0u; mine = (j == x) ? c : mine; }
    if (sum == G) break;
    __builtin_amdgcn_s_sleep(1);
    if ((++sp & 255u) == 0u) { if (xb_ld(&bar[XB_TMO])) break; if (sp > XB_SPIN_CAP) { atomicAdd(&bar[XB_TMO], 1u); break; } }
  }
  nloc = mine > 0u ? mine : 1u; nx = cnt > 0u ? cnt : 1u;
}
DI void xcd_barrier(const XcdBarrier& b, const int wid_s) {
  asm volatile("s_waitcnt vmcnt(0)" ::: "memory");
  __syncthreads();
  int w0 = wid_s; asm volatile("" : "+s"(w0));
  if (w0 == 0 && lane_id_hw() == 0) {
    unsigned* bar = b.bar;
    __builtin_amdgcn_s_waitcnt(0);
    unsigned nloc = b.st[0], nx = b.st[1];
    if (nloc == 0u) { xcd_barrier_complete(bar, b.x, nloc, nx); b.st[0] = nloc; b.st[1] = nx; }
    const unsigned old = xb_add(&bar[XB_XSUB(b.x)], 1u);
    const unsigned gen = old / nloc;
    if (old + 1u == (gen + 1u) * nloc) {
      __builtin_amdgcn_fence(__ATOMIC_RELEASE, "agent");
      asm volatile("s_waitcnt vmcnt(0)" ::: "memory");
      const unsigned og = xb_add(&bar[XB_TOP], 1u);
      const unsigned tg = og / nx;
      if (og + 1u == (tg + 1u) * nx) xb_add(&bar[XB_TOPGEN], 1u);
      else XB_SPIN(xb_ld(&bar[XB_TOPGEN]) == tg, bar);
      __builtin_amdgcn_fence(__ATOMIC_ACQUIRE, "agent");
      xb_add(&bar[XB_XGEN(b.x)], 1u);
      asm volatile("s_waitcnt vmcnt(0)" ::: "memory");
    } else {
      XB_SPIN(xb_ld(&bar[XB_XGEN(b.x)]) == gen, bar);
      __builtin_amdgcn_fence(__ATOMIC_ACQUIRE, "agent");
      asm volatile("s_waitcnt vmcnt(0)" ::: "memory");
    }
  }
  __syncthreads();
}

__global__ void __launch_bounds__(512) hymba_fwd(const Params p) {
  cg::grid_group grid = cg::this_grid();
  unsigned char* ws0 = p.ws;
  volatile LAS unsigned* st = (volatile LAS unsigned*)((LAS unsigned char*)smem + 131072);
  const int wid_s = __builtin_amdgcn_readfirstlane((int)(threadIdx.x >> 6));
  if (threadIdx.x == 0) { st[0] = 0u; st[1] = 0u; st[2] = 0u; st[3] = blockIdx.x; }
  __syncthreads();
  const XcdBarrier xb = xcd_barrier_post((unsigned*)(ws0 + OFF_BAR), st, threadIdx.x == 0);
  for (int ph = p.phase_lo; ph < p.phase_hi; ++ph) {
    if (ph > p.phase_lo) {
      int ucg = p.use_cg; asm volatile("" : "+s"(ucg));
      if (ucg) grid.sync(); else xcd_barrier(xb, wid_s);
      if (ph == p.phase_lo + 1 && !ucg && gridDim.x == 256) {
        int w1 = wid_s; asm volatile("" : "+s"(w1));
        if (w1 == 0 && lane_id_hw() == 0) {
          unsigned* bar = (unsigned*)(ws0 + OFF_BAR);
          bool ok = true;
          for (unsigned j = 0; j < 16; ++j) { const unsigned c = xb_ld(&bar[XB_XCNT(j)]); ok = ok && (c == (j < 8 ? 32u : 0u)); }
          const unsigned rank = st[2];
          if (ok && rank < 32u && xb.x < 8u) st[3] = rank * 8u + xb.x;
        }
        __syncthreads();
      }
    }
    const int l = ph == 0 ? 0 : (ph - 1) >> 3, s = ph == 0 ? 8 : (ph - 1) & 7;
    Params pl = p;
    { unsigned char* wl = p.ws; asm volatile("" : "+s"(wl)); pl.ws = wl; }
    unsigned char* ws = pl.ws;
    const int reps = ((p.probe_mask >> s) & 1) ? 2 : 1;
    h16* xa = (h16*)(ws + OFF_XA); h16* mix = (h16*)(ws + OFF_MIX); h16* y = (h16*)(ws + OFF_Y); h16* hbuf = (h16*)(ws + OFF_H);
    for (int rep = 0; rep < reps; ++rep) {
    if (s == 8) prologue(pl, wid_s);
    else if (s == 0) { EpiArgs ea{hbuf, nullptr}; gemm_phase<0>(wid_s, xa, (const h16*)(ws + OFF_WIN + l * SZ_WIN), LDH, 1024, ea); }
    else if (s == 1) mixers_phase(pl, l, wid_s);
    else if (s == 2) attn_phase(pl, l, wid_s);
    else if (s == 3) { EpiArgs ea{y, xa}; gemm_phase<1>(wid_s, mix, (const h16*)(ws + OFF_WOUT + l * SZ_WOUT), 1024, 1024, ea); }
    else if (s == 4) ln_phase(wid_s, y, pl.ln1_g + l * 1024, pl.ln1_b + l * 1024, xa, nullptr);
    else if (s == 5) { EpiArgs ea{hbuf, nullptr}; gemm_phase<2>(wid_s, xa, (const h16*)(ws + OFF_WGU + l * SZ_WGU), 5632, 1024, ea); }
    else if (s == 6) { EpiArgs ea{y, xa}; gemm_phase<1>(wid_s, hbuf, (const h16*)(ws + OFF_WDN + l * SZ_WDN), 1024, DFF, ea); }
    else ln_phase(wid_s, y, pl.ln2_g + l * 1024, pl.ln2_b + l * 1024, l == 1 ? (h16*)nullptr : xa, l == 1 ? pl.out : nullptr);
    }
  }
}

#ifndef USE_CG_SYNC
#define USE_CG_SYNC 0
#endif
#ifndef PROBE_MASK
#define PROBE_MASK 0
#endif
#ifndef SINGLE_LAUNCH
#define SINGLE_LAUNCH 1
#endif

extern "C" void kernel_launch(void* const* d_in, const int* in_sizes, int n_in, void* d_out, int out_size, void* d_ws, size_t ws_size, hipStream_t stream) {
  static int grid_blocks = 0;
  if (!grid_blocks) {
    int dev = 0, cus = 0, per_cu = 0;
    hipGetDevice(&dev);
    hipDeviceGetAttribute(&cus, hipDeviceAttributeMultiprocessorCount, dev);
    hipFuncSetAttribute((const void*)hymba_fwd, hipFuncAttributeMaxDynamicSharedMemorySize, LDS_BYTES);
    hipOccupancyMaxActiveBlocksPerMultiprocessor(&per_cu, hymba_fwd, 512, LDS_BYTES);
    if (per_cu < 1) per_cu = 1;
    grid_blocks = cus * per_cu;
    if (ws_size < WS_NEED) fprintf(stderr, "workspace too small: %zu < %zu\n", ws_size, (size_t)WS_NEED);
  }
  Params p{};
  p.x = (const float*)d_in[0]; p.w_in = (const float*)d_in[1]; p.conv_w = (const float*)d_in[2]; p.cmp_pe = (const float*)d_in[3];
  p.cmp_w1 = (const float*)d_in[4]; p.cmp_w2 = (const float*)d_in[5]; p.pool_w = (const float*)d_in[6]; p.pool_scale = (const float*)d_in[7];
  p.w_out = (const float*)d_in[8]; p.ln1_g = (const float*)d_in[9]; p.ln1_b = (const float*)d_in[10]; p.w_gate = (const float*)d_in[11];
  p.w_up = (const float*)d_in[12]; p.w_down = (const float*)d_in[13]; p.ln2_g = (const float*)d_in[14]; p.ln2_b = (const float*)d_in[15];
  p.rel_bias = (const float*)d_in[16];
  p.out = (float*)d_out; p.ws = (unsigned char*)d_ws; p.probe_mask = PROBE_MASK; p.use_cg = USE_CG_SYNC;
#if SINGLE_LAUNCH
  hipMemsetAsync((unsigned char*)d_ws + OFF_BAR, 0, 16384, stream);
  p.phase_lo = 0; p.phase_hi = NPHASE;
  void* args[] = {&p};
  hipError_t e = hipLaunchCooperativeKernel((const void*)hymba_fwd, dim3(grid_blocks), dim3(512), args, LDS_BYTES, stream);
  if (e != hipSuccess) fprintf(stderr, "cooperative launch failed: %s (grid %d)\n", hipGetErrorString(e), grid_blocks);
#else
  for (int ph = 0; ph < NPHASE; ++ph) {
    p.phase_lo = ph; p.phase_hi = ph + 1;
    hipLaunchKernelGGL(hymba_fwd, dim3(grid_blocks), dim3(512), LDS_BYTES, stream, p);
  }
#endif
}
```
